# Optimizing an MI355X kernel written in HIP

```python
import math
import jax, jax.numpy as jnp
from jax import lax
import numpy as np

D_MODEL = 2048
BATCH = 8
SEQ = 2048
DEPTH = 2

GRID_W = 64
CTX_LEN = 256
FN_WIDTH = D_MODEL // 4
FN_GROUPS = 4
HY_WIDTH = D_MODEL // 4
HG_WIDTH = D_MODEL // 2
HG_HEAD_DIM = 128
HG_HEADS = HG_WIDTH // HG_HEAD_DIM
HG_CHUNK = 64
HG_F_MIN = 1e-6
MIX_WIDTH = FN_WIDTH + HY_WIDTH + HG_WIDTH
HY_OFF = FN_WIDTH
HG_OFF = FN_WIDTH + 3 * HY_WIDTH
IN_WIDTH = FN_WIDTH + 3 * HY_WIDTH + 5 * HG_WIDTH
HY_EMB = 33
HY_BANDS = (HY_EMB - 1) // 2
HY_HIDDEN = 64
HY_SHORT = 3
HY_FAST_DECAY = 0.3
HY_SLOW_DECAY = 1.5
HY_TARGET = 1e-2
N_EXPERTS = 16
EC_CAPACITY = 2
EXPERT_FF = D_MODEL // 2
EPS = 1e-6

kernel_name = "hybrid_fnet_hyena_hgrn2_ec_moe_prefix_dit"

F32 = jnp.float32


def rmsnorm(x, g):
    x32 = x.astype(F32)
    y = x32 * lax.rsqrt(jnp.mean(x32 * x32, axis=-1, keepdims=True) + EPS)
    return (y * g.astype(F32)).astype(x.dtype)


def modulate(h, shift, scale):
    return h * (1 + scale) + shift


def fourier_mix(u, w_fn):
    B, L, _ = u.shape
    ug = u.astype(F32).reshape(B, L, FN_GROUPS, FN_WIDTH // FN_GROUPS)
    y = jnp.fft.fft2(ug, axes=(1, 3), norm="ortho").real.reshape(B, L, FN_WIDTH)
    return y.astype(u.dtype) @ w_fn


def short_conv(u, w, b):
    L = u.shape[1]
    half = HY_SHORT // 2
    up = jnp.pad(u, ((0, 0), (half, half), (0, 0)))
    return sum(up[:, j:j + L] * w[j] for j in range(HY_SHORT)) + b


def hyena_filters(L, w1, b1, w2, b2, w3, b3, w_out, freq):
    pos = jnp.arange(L, dtype=F32)
    t = (pos / max(L - 1, 1))[:, None]
    bands = jnp.linspace(1e-4, HY_BANDS - 1, HY_BANDS, dtype=F32)
    w = 2.0 * math.pi * pos[:, None] / L
    z = jnp.concatenate([t, jnp.cos(bands * w), -jnp.sin(bands * w)], axis=-1)
    hdn = jnp.sin(freq[0] * (z @ w1 + b1))
    hdn = jnp.sin(freq[1] * (hdn @ w2 + b2))
    hdn = jnp.sin(freq[2] * (hdn @ w3 + b3))
    h = (hdn @ w_out).astype(F32).reshape(L, 2, HY_WIDTH)
    max_decay = math.log(HY_TARGET) / HY_FAST_DECAY
    min_decay = math.log(HY_TARGET) / HY_SLOW_DECAY
    deltas = jnp.linspace(min_decay, max_decay, HY_WIDTH, dtype=F32)
    decay = jnp.exp(-t * jnp.abs(deltas))
    h = h * decay[:, None, :]
    return h[:, 0], h[:, 1]


def bidir_long_conv(u, h_f, h_b, d_bias):
    B, L, C = u.shape
    k = jnp.concatenate([h_f, jnp.zeros((1, C), F32), h_b[1:][::-1]], axis=0)
    U = jnp.fft.rfft(u.astype(F32), n=2 * L, axis=1)
    K = jnp.fft.rfft(k, axis=0)
    y = jnp.fft.irfft(U * K[None], n=2 * L, axis=1)[:, :L]
    return (y + u.astype(F32) * d_bias.astype(F32)).astype(u.dtype)


def hyena_mix(u3, conv_w, conv_b, w1, b1, w2, b2, w3, b3, w_out, freq, d_bias):
    L = u3.shape[1]
    uc = short_conv(u3, conv_w, conv_b)
    v = uc[..., :HY_WIDTH]
    x1 = uc[..., HY_WIDTH:2 * HY_WIDTH]
    x0 = uc[..., 2 * HY_WIDTH:]
    h_f, h_b = hyena_filters(L, w1, b1, w2, b2, w3, b3, w_out, freq)
    return x0 * bidir_long_conv(x1 * v, h_f, h_b, d_bias)


def hgrn2_chunk_scan(q, k, logf, v, s0):
    B, L, H, _ = q.shape
    DV = v.shape[-1]
    n = L // HG_CHUNK

    def chunks(a):
        return a.reshape(B, n, HG_CHUNK, H, a.shape[-1]).transpose(1, 0, 3, 2, 4)

    mask = jnp.tril(jnp.ones((HG_CHUNK, HG_CHUNK), dtype=bool))[:, :, None]

    def step(S, inp):
        qc, kc, gc, vc = inp
        b = jnp.cumsum(gc, axis=2)
        o_inter = jnp.einsum('bhtk,bhkv->bhtv', qc * jnp.exp(b), S)
        diff = b[:, :, :, None, :] - b[:, :, None, :, :]
        decay = jnp.where(mask, jnp.exp(jnp.where(mask, diff, 0.0)), 0.0)
        a = jnp.einsum('bhtk,bhsk,bhtsk->bhts', qc, kc, decay)
        o = o_inter + jnp.einsum('bhts,bhsv->bhtv', a, vc)
        b_last = b[:, :, -1]
        S = jnp.exp(b_last)[..., None] * S + jnp.einsum(
            'bhsk,bhsv->bhkv', kc * jnp.exp(b_last[:, :, None] - b), vc)
        return S, o

    S, o = lax.scan(step, s0, (chunks(q), chunks(k), chunks(logf), chunks(v)))
    o = o.transpose(1, 0, 3, 2, 4).reshape(B, L, H, DV)
    return o, S


def hgrn2_bidir(p_hg, lb_f, lb_b, s0_f, s0_b):
    B, L, _ = p_hg.shape
    W = HG_WIDTH
    zq, zf, zb, zi, g = (p_hg[..., j * W:(j + 1) * W] for j in range(5))

    def heads(a):
        return a.astype(F32).reshape(B, L, HG_HEADS, HG_HEAD_DIM)

    q = heads(jax.nn.silu(zq))
    v = heads(zi)

    def direction(z, lb, s0, flip):
        lb = lb.astype(F32)
        f = jnp.maximum(lb + (1.0 - lb) * jax.nn.sigmoid(z.astype(F32)), HG_F_MIN)
        logf = heads(jnp.log(f))
        k = heads(1.0 - f)
        qq, vv = q, v
        if flip:
            qq, k, logf, vv = qq[:, ::-1], k[:, ::-1], logf[:, ::-1], vv[:, ::-1]
        o, S = hgrn2_chunk_scan(qq, k, logf, vv, s0)
        if flip:
            o = o[:, ::-1]
        return o, S

    o_f, s_f = direction(zf, lb_f, s0_f, False)
    o_b, s_b = direction(zb, lb_b, s0_b, True)
    return o_f + o_b, g, s_f, s_b


def hgrn2_out(o, g, gain):
    B, L = o.shape[:2]
    y = o * lax.rsqrt(jnp.mean(o * o, axis=-1, keepdims=True) + EPS)
    y = y * gain.astype(F32).reshape(HG_HEADS, HG_HEAD_DIM)
    return (y.reshape(B, L, HG_WIDTH) * jax.nn.silu(g.astype(F32))).astype(g.dtype)


def ec_moe(h, w_router, w_gate, w_up, w_down):
    B, L, D = h.shape
    cap = EC_CAPACITY * L // N_EXPERTS
    aff = jax.nn.softmax((h @ w_router).astype(F32), axis=-1)
    gates, idx = lax.top_k(jnp.swapaxes(aff, 1, 2), cap)
    xs = jax.vmap(lambda hb, ib: hb[ib])(h, idx)
    hid = jax.nn.silu(jnp.einsum('becd,edf->becf', xs, w_gate)) * jnp.einsum('becd,edf->becf', xs, w_up)
    ys = jnp.einsum('becf,efd->becd', hid, w_down) * gates[..., None].astype(h.dtype)
    return jax.vmap(lambda ib, yb: jnp.zeros((L, D), yb.dtype).at[ib.reshape(-1)].add(yb.reshape(-1, D)))(idx, ys)


def setup_inputs(seed: int = 0) -> dict:
    key = jax.random.key(seed)
    ks = jax.random.split(key, 32)
    nrm = lambda k, shape, s: jax.random.normal(k, shape, F32) * s
    D = D_MODEL
    return {
        "x": nrm(ks[0], (BATCH, SEQ, D), 1.0),
        "c": nrm(ks[1], (BATCH, D), 1.0),
        "ctx": nrm(ks[2], (BATCH, CTX_LEN, D), 1.0),
        "c_ctx": nrm(ks[3], (D,), 1.0),
        "norm_mix_g": 1.0 + nrm(ks[4], (DEPTH, D), 0.05),
        "norm_ffn_g": 1.0 + nrm(ks[5], (DEPTH, D), 0.05),
        "final_norm_g": 1.0 + nrm(ks[6], (D,), 0.05),
        "w_mod": nrm(ks[7], (DEPTH, D, 6 * D), D ** -0.5),
        "b_mod": nrm(ks[8], (DEPTH, 6 * D), 0.02),
        "w_in": nrm(ks[9], (DEPTH, D, IN_WIDTH), D ** -0.5),
        "w_out": nrm(ks[10], (DEPTH, MIX_WIDTH, D), MIX_WIDTH ** -0.5),
        "w_fnet": nrm(ks[11], (DEPTH, FN_WIDTH, FN_WIDTH), FN_WIDTH ** -0.5),
        "hy_conv_w": nrm(ks[12], (DEPTH, HY_SHORT, 3 * HY_WIDTH), HY_SHORT ** -0.5),
        "hy_conv_b": nrm(ks[13], (DEPTH, 3 * HY_WIDTH), 0.02),
        "hy_w1": nrm(ks[14], (DEPTH, HY_EMB, HY_HIDDEN), HY_EMB ** -0.5),
        "hy_b1": nrm(ks[15], (DEPTH, HY_HIDDEN), 0.02),
        "hy_w2": nrm(ks[16], (DEPTH, HY_HIDDEN, HY_HIDDEN), HY_HIDDEN ** -0.5),
        "hy_b2": nrm(ks[17], (DEPTH, HY_HIDDEN), 0.02),
        "hy_w3": nrm(ks[18], (DEPTH, HY_HIDDEN, HY_HIDDEN), HY_HIDDEN ** -0.5),
        "hy_b3": nrm(ks[19], (DEPTH, HY_HIDDEN), 0.02),
        "hy_w_out": nrm(ks[20], (DEPTH, HY_HIDDEN, 2 * HY_WIDTH), 0.1 * HY_HIDDEN ** -0.5),
        "hy_freq": 1.0 + nrm(ks[21], (DEPTH, 3, HY_HIDDEN), 0.1),
        "hy_bias": nrm(ks[22], (DEPTH, HY_WIDTH), 0.5),
        "hg_lb": nrm(ks[23], (DEPTH, 2, HG_WIDTH), 0.5),
        "hg_norm_g": 1.0 + nrm(ks[24], (DEPTH, HG_WIDTH), 0.05),
        "w_router": nrm(ks[25], (DEPTH, D, N_EXPERTS), D ** -0.5),
        "w_gate": nrm(ks[26], (DEPTH, N_EXPERTS, D, EXPERT_FF), D ** -0.5),
        "w_up": nrm(ks[27], (DEPTH, N_EXPERTS, D, EXPERT_FF), D ** -0.5),
        "w_down": nrm(ks[28], (DEPTH, N_EXPERTS, EXPERT_FF, D), EXPERT_FF ** -0.5),
    }


def reference(x, c, ctx, c_ctx, norm_mix_g, norm_ffn_g, final_norm_g, w_mod, b_mod, w_in, w_out, w_fnet,
              hy_conv_w, hy_conv_b, hy_w1, hy_b1, hy_w2, hy_b2, hy_w3, hy_b3, hy_w_out, hy_freq, hy_bias,
              hg_lb, hg_norm_g, w_router, w_gate, w_up, w_down):
    B = x.shape[0]
    p = jax.nn.softmax(hg_lb.astype(F32), axis=0)
    lbs = jnp.cumsum(p, axis=0) - p[0:1]
    xc = ctx
    for l in range(DEPTH):
        last = l == DEPTH - 1
        mod = (jax.nn.silu(c) @ w_mod[l] + b_mod[l])[:, None, :]
        mod_c = jax.nn.silu(c_ctx) @ w_mod[l] + b_mod[l]
        sh1, sc1, g1, sh2, sc2, g2 = jnp.split(mod, 6, axis=-1)
        csh1, csc1, cg1, csh2, csc2, cg2 = jnp.split(mod_c, 6, axis=-1)
        hy_args = (hy_conv_w[l], hy_conv_b[l], hy_w1[l], hy_b1[l], hy_w2[l], hy_b2[l],
                   hy_w3[l], hy_b3[l], hy_w_out[l], hy_freq[l], hy_bias[l])

        def mixers_out(h, o_hg, g_hg):
            y_fn = fourier_mix(h[..., :FN_WIDTH], w_fnet[l])
            y_hy = hyena_mix(h[..., HY_OFF:HG_OFF], *hy_args)
            y_hg = hgrn2_out(o_hg, g_hg, hg_norm_g[l])
            return jnp.concatenate([y_fn, y_hy, y_hg], axis=-1) @ w_out[l]

        h = modulate(rmsnorm(x, norm_mix_g[l]), sh1, sc1) @ w_in[l]
        hc = modulate(rmsnorm(xc, norm_mix_g[l]), csh1, csc1) @ w_in[l]
        zero = jnp.zeros((B, HG_HEADS, HG_HEAD_DIM, HG_HEAD_DIM), F32)
        o_c, g_c, s_f, s_b = hgrn2_bidir(hc[..., HG_OFF:], lbs[l, 0], lbs[l, 1], zero, zero)
        o_x, g_x, _, _ = hgrn2_bidir(h[..., HG_OFF:], lbs[l, 0], lbs[l, 1], s_f, s_b)
        x = x + g1 * mixers_out(h, o_x, g_x)
        if not last:
            xc = xc + cg1 * mixers_out(hc, o_c, g_c)
        x = x + g2 * ec_moe(modulate(rmsnorm(x, norm_ffn_g[l]), sh2, sc2),
                            w_router[l], w_gate[l], w_up[l], w_down[l])
        if not last:
            xc = xc + cg2 * ec_moe(modulate(rmsnorm(xc, norm_ffn_g[l]), csh2, csc2),
                                   w_router[l], w_gate[l], w_up[l], w_down[l])
    return rmsnorm(x, final_norm_g)
```

```cpp
#include <hip/hip_runtime.h>
#include <cstdio>
#include <cstdint>

#ifndef MK_MULTI
#define MK_MULTI 0
#endif

#define LAS __attribute__((address_space(3)))
#define GAS __attribute__((address_space(1)))
typedef unsigned short bf16_t;
typedef short bf16x8 __attribute__((ext_vector_type(8)));
typedef float f32x4 __attribute__((ext_vector_type(4)));
typedef float f32x2 __attribute__((ext_vector_type(2)));
typedef unsigned u32x4 __attribute__((ext_vector_type(4)));
typedef unsigned u32x2 __attribute__((ext_vector_type(2)));

constexpr int D = 2048, NB = 8, LX = 2048, LC = 256;
constexpr int TX = NB * LX, TC = NB * LC, TT = TX + TC;
constexpr int NIN = 7680;
constexpr int HGW = 5120;
constexpr int NE = 16, FF = 1024, CAPX = 256, CAPC = 32, ROWS_E = NB * (CAPX + CAPC);
constexpr int MODW = 6 * D;
constexpr float EPS = 1e-6f;
constexpr int KRX_LD = 2 * LX + 8, KRC_LD = 2 * LC + 8;

constexpr size_t MiB = 1u << 20;
constexpr size_t WS_CTL = 0, CTL_ZERO_BYTES = 1 * MiB;
constexpr size_t WS_MOD = 1 * MiB;
constexpr size_t WS_DFTX = 2 * MiB;
constexpr size_t WS_DFTC = WS_DFTX + 16 * MiB;
constexpr size_t WS_KRX = WS_DFTC + 1 * MiB;
constexpr size_t WS_KRC = WS_KRX + 9 * MiB;
constexpr size_t WS_AFF = WS_KRC + 2 * MiB;
constexpr size_t WS_SLOT = WS_AFF + 2 * MiB;
constexpr size_t WS_IDX = WS_SLOT + 2 * MiB;
constexpr size_t WS_GATE = WS_IDX + 1 * MiB;
constexpr size_t WS_WIN = WS_GATE + 1 * MiB;
constexpr size_t WIN_BYTES = (size_t)NIN * D * 2;
constexpr size_t WS_WOUT = WS_WIN + 2 * WIN_BYTES;
constexpr size_t WOUT_BYTES = (size_t)D * D * 2;
constexpr size_t WS_WGU = WS_WOUT + 2 * WOUT_BYTES;
constexpr size_t WGU_BYTES = (size_t)NE * 2 * FF * D * 2;
constexpr size_t WS_WD = WS_WGU + 2 * WGU_BYTES;
constexpr size_t WD_BYTES = (size_t)NE * D * FF * 2;
constexpr size_t WS_XCUR = WS_WD + 2 * WD_BYTES;
constexpr size_t WS_XM = WS_XCUR + (size_t)TT * D * 2;
constexpr size_t WS_OVL = WS_XM + (size_t)TT * D * 2;
constexpr size_t WS_FTX = WS_OVL;
constexpr size_t WS_FTC = WS_FTX + (size_t)NB * 512 * 4096 * 2;
constexpr size_t WS_HTX = WS_FTC + (size_t)NB * 512 * 512 * 2;
constexpr size_t WS_HTC = WS_HTX + (size_t)NB * 1536 * LX * 2;
constexpr size_t WS_HG = WS_HTC + (size_t)NB * 1536 * LC * 2;
constexpr size_t WS_OF = WS_HG + (size_t)TT * HGW * 2;
constexpr size_t WS_OB = WS_OF + (size_t)TT * 1024 * 2;
constexpr size_t WS_MIX = WS_OB + (size_t)TT * 1024 * 2;
constexpr size_t WS_END_MIXER = WS_MIX + (size_t)TT * D * 2;
constexpr size_t WS_XS = WS_OVL;
constexpr size_t WS_HID = WS_XS + (size_t)NE * ROWS_E * D * 2;
constexpr size_t WS_Y = WS_HID + (size_t)NE * ROWS_E * FF * 2;
constexpr size_t WS_END_MOE = WS_Y + (size_t)NE * ROWS_E * D * 2;
constexpr size_t WS_END = WS_END_MIXER > WS_END_MOE ? WS_END_MIXER : WS_END_MOE;

constexpr int CW_BAR = 4096;
constexpr int CW_QUEUE = 16384;

constexpr int LDS_BYTES = 155648;
constexpr int LDS_CTL = LDS_BYTES - 256;

__device__ __forceinline__ unsigned f2bf(float f) { unsigned u = __builtin_bit_cast(unsigned, f); return (u + 0x7fffu + ((u >> 16) & 1u)) >> 16; }
typedef __bf16 bf16x2_t __attribute__((ext_vector_type(2)));
__device__ __forceinline__ unsigned pk2(float lo, float hi) { const f32x2 v = {lo, hi}; return __builtin_bit_cast(unsigned, __builtin_convertvector(v, bf16x2_t)); }
__device__ __forceinline__ float bf2f(unsigned short h) { return __builtin_bit_cast(float, (unsigned)h << 16); }
__device__ __forceinline__ float bflo(unsigned w) { return __builtin_bit_cast(float, w << 16); }
__device__ __forceinline__ float bfhi(unsigned w) { return __builtin_bit_cast(float, w & 0xffff0000u); }
__device__ __forceinline__ float shx(float v, int mask, int lane) { return __builtin_bit_cast(float, __builtin_amdgcn_ds_bpermute((lane ^ mask) << 2, __builtin_bit_cast(int, v))); }
__device__ __forceinline__ float wave_sum(float v, int lane) {
#pragma unroll
    for (int o = 1; o < 64; o <<= 1) v += shx(v, o, lane);
    return v;
}
__device__ __forceinline__ float sigmoidf_(float z) { return __builtin_amdgcn_rcpf(1.0f + __builtin_amdgcn_exp2f(-1.44269504089f * z)); }
__device__ __forceinline__ int opaque(int v) { asm volatile("" : "+v"(v)); return v; }
__device__ __forceinline__ int lane_id_() { int v; asm volatile("v_mbcnt_lo_u32_b32 %0, -1, 0\n\tv_mbcnt_hi_u32_b32 %0, -1, %0" : "=v"(v)); return v; }
#define TIDX(a) (((a).wv << 6) | lane_id_())
#define LDS_WAIT() asm volatile("s_waitcnt lgkmcnt(0)" ::: "memory")

#define XB_TMO      128
#define XB_XCNT(j)  (256  + 64 * (j))
#define XB_XSUB(j)  (1280 + 64 * (j))
#define XB_XGEN(j)  (2304 + 64 * (j))
#define XB_TOP      3328
#define XB_TOPGEN   3392
#define XCD_BAR_WORDS 3456
#define XB_SPIN_CAP (1u << 18)
__device__ __forceinline__ unsigned xb_ld(unsigned* p)              { return __hip_atomic_load(p, __ATOMIC_RELAXED, __HIP_MEMORY_SCOPE_AGENT); }
__device__ __forceinline__ unsigned xb_add(unsigned* p, unsigned v) { return __hip_atomic_fetch_add(p, v, __ATOMIC_RELAXED, __HIP_MEMORY_SCOPE_AGENT); }
__device__ __forceinline__ unsigned xb_xcc_id() { return (unsigned)__builtin_amdgcn_s_getreg((3 << 11) | 20) & 0xFu; }
#define XB_SPIN(cond, bar) do { unsigned _sp = 0; while (cond) { __builtin_amdgcn_s_sleep(1); \
    if ((++_sp & 255u) == 0u) { if (xb_ld(&(bar)[XB_TMO])) break; if (_sp > XB_SPIN_CAP) { atomicAdd(&(bar)[XB_TMO], 1u); break; } } } } while (0)
struct XcdBarrier { unsigned* bar; unsigned x; volatile LAS unsigned* st; int wv; };
__device__ __forceinline__ XcdBarrier xcd_barrier_post(unsigned* bar, volatile LAS unsigned* st, int wv) {
    XcdBarrier b; b.bar = bar; b.x = xb_xcc_id(); b.st = st; b.wv = wv;
    if (wv == 0 && lane_id_() == 0) (void)xb_add(&bar[XB_XCNT(b.x)], 1u);
    return b;
}
__device__ __forceinline__ void xcd_barrier_complete(unsigned* bar, unsigned x, unsigned& nloc, unsigned& nx) {
    const unsigned G = gridDim.x * gridDim.y * gridDim.z;
    unsigned sum, cnt, mine, sp = 0u;
    for (;;) {
        sum = 0u; cnt = 0u; mine = 0u;
#pragma unroll
        for (unsigned j = 0; j < 16; ++j) { const unsigned c = xb_ld(&bar[XB_XCNT(j)]); sum += c; cnt += (c > 0u) ? 1u : 0u; mine = (j == x) ? c : mine; }
        if (sum == G) break;
        __builtin_amdgcn_s_sleep(1);
        if ((++sp & 255u) == 0u) { if (xb_ld(&bar[XB_TMO])) break; if (sp > XB_SPIN_CAP) { atomicAdd(&bar[XB_TMO], 1u); break; } }
    }
    nloc = mine > 0u ? mine : 1u; nx = cnt > 0u ? cnt : 1u;
}
__device__ __forceinline__ void xcd_barrier(const XcdBarrier& b) {
    asm volatile("s_waitcnt vmcnt(0)" ::: "memory");
    __syncthreads();
    if (b.wv == 0 && lane_id_() == 0) {
        unsigned* bar = b.bar; asm volatile("" : "+s"(bar));
        __builtin_amdgcn_s_waitcnt(0);
        unsigned nloc = b.st[0], nx = b.st[1];
        if (nloc == 0u) { xcd_barrier_complete(bar, b.x, nloc, nx); b.st[0] = nloc; b.st[1] = nx; }
        const unsigned old = xb_add(&bar[XB_XSUB(b.x)], 1u);
        const unsigned gen = old / nloc;
        if (old + 1u == (gen + 1u) * nloc) {
            __builtin_amdgcn_fence(__ATOMIC_RELEASE, "agent");
            asm volatile("s_waitcnt vmcnt(0)" ::: "memory");
            const unsigned og = xb_add(&bar[XB_TOP], 1u);
            const unsigned tg = og / nx;
            if (og + 1u == (tg + 1u) * nx) xb_add(&bar[XB_TOPGEN], 1u);
            else XB_SPIN(xb_ld(&bar[XB_TOPGEN]) == tg, bar);
            __builtin_amdgcn_fence(__ATOMIC_ACQUIRE, "agent");
            xb_add(&bar[XB_XGEN(b.x)], 1u);
            asm volatile("s_waitcnt vmcnt(0)" ::: "memory");
        } else {
            XB_SPIN(xb_ld(&bar[XB_XGEN(b.x)]) == gen, bar);
            __builtin_amdgcn_fence(__ATOMIC_ACQUIRE, "agent");
            asm volatile("s_waitcnt vmcnt(0)" ::: "memory");
        }
    }
    __syncthreads();
}

#ifndef KLOOP_V
#define KLOOP_V 0
#endif
namespace pg8 {
constexpr int BM = 256, BK = 64, HALF = 128, HTB = HALF * BK * 2, STAGE_BYTES = 8 * HTB, NXCD = 8, WGM = 4;
constexpr int GIDX_UNITS = 5;
constexpr int EPI_SCR = STAGE_BYTES + GIDX_UNITS * 1024, EPI_RS = 144, EPI_WSZ = 16 * EPI_RS;
static_assert(EPI_SCR + 8 * EPI_WSZ <= LDS_CTL, "epilogue scratch");
__host__ __device__ __forceinline__ int lds_byte(int r, int c) { const int x = r & 7; return (r >> 3) * 1024 + x * 128 + (((c >> 3) ^ (x & 6)) << 4) + (c & 7) * 2; }
__host__ __device__ __forceinline__ void stage_rc(int b, int& R, int& C) { const int st = b / 1024, sb = b % 1024, x = sb / 128, cp = (sb % 128) / 16; R = st * 8 + x; C = ((cp ^ (x & 6)) << 3) + (sb % 16) / 2; }
struct Unit { const char* A; const char* B; int pm, pn, aux; };
__device__ __forceinline__ void tile_of(int L, int nM, int nN, int& pm, int& pn) {
    const int nwg = nM * nN; int wgid = L;
    { const int q = nwg / NXCD, r = nwg % NXCD, xcd = wgid % NXCD, off = wgid / NXCD; wgid = (xcd < r ? xcd * (q + 1) : r * (q + 1) + (xcd - r) * q) + off; }
    const int nig = WGM * nN, gid = wgid / nig, fm = gid * WGM, gsz = (nM - fm) < WGM ? (nM - fm) : WGM;
    pm = fm + ((wgid % nig) % gsz); pn = (wgid % nig) / gsz;
}
template <class Epi, class Sched, bool ALIGN_EPI = true, bool SP2 = true, bool GATHER = false, bool PERMB = true>
__device__ __forceinline__ void gemm_phase(LAS unsigned char* lds, const int lda, const int ldb, const int K, const Sched& S, const Epi& E, const int wv, const LAS int* gidx = nullptr) {
    const int tid = opaque((wv << 6) | lane_id_()), wid = __builtin_amdgcn_readfirstlane(tid >> 6), lane = tid & 63, wr = wid >> 2, wc = wid & 3, fr = lane & 15, fq = lane >> 4;
    const int nt = K / BK;
    int sR[2], sC[2];
    unsigned vA[2][2], vN[2][2], voffB[2];
#pragma unroll
    for (int i = 0; i < 2; ++i) { stage_rc(tid * 16 + i * 8192, sR[i], sC[i]); voffB[i] = (unsigned)((PERMB ? 64 * (sR[i] >> 5) + (sR[i] & 31) : sR[i]) * ldb + sC[i]) * 2u; }
    const size_t kstep = (size_t)(BK * 2);
    const size_t hstepB = (size_t)(PERMB ? 32 : HALF) * ldb * 2;
    LAS unsigned char* const escr = lds + EPI_SCR + wid * EPI_WSZ;
    const unsigned ldsw = (unsigned)wid * 1024u;
    const int aoff[2] = {lds_byte(wr * 64 + fr, fq * 8), lds_byte(wr * 64 + fr, 32 + fq * 8)}, boff[2] = {lds_byte(wc * 32 + fr, fq * 8), lds_byte(wc * 32 + fr, 32 + fq * 8)};
#define PG8_SA(b, h) (((b) * 2 + (h)) * HTB)
#define PG8_SB(b, h) ((4 + (b) * 2 + (h)) * HTB)
#ifndef B_AUX
#define B_AUX 0
#endif
#define PG8_STAGE_X(bufoff, gbase, voff, aux) do { _Pragma("unroll") for (int _i = 0; _i < 2; ++_i) \
        __builtin_amdgcn_global_load_lds((const unsigned*)((const char*)(gbase) + (voff)[_i]), (LAS unsigned*)(lds + (bufoff) + ldsw + _i * 8192), 16, 0, aux); } while (0)
#define PG8_STAGE(bufoff, gbase, voff) PG8_STAGE_X(bufoff, gbase, voff, 0)
#define PG8_VOFF(dst, slot) do { _Pragma("unroll") for (int _h = 0; _h < 2; ++_h) _Pragma("unroll") for (int _i = 0; _i < 2; ++_i) \
        dst[_h][_i] = GATHER ? ((unsigned)gidx[(slot) * 256 + _h * HALF + sR[_i]] * (unsigned)lda + (unsigned)sC[_i]) * 2u : (unsigned)((_h * HALF + sR[_i]) * lda + sC[_i]) * 2u; } while (0)
#define PG8_LDA(dst, b, h) do { _Pragma("unroll") for (int m = 0; m < 4; ++m) _Pragma("unroll") for (int k = 0; k < 2; ++k) dst[m][k] = *(const LAS bf16x8*)(lds + PG8_SA(b, h) + aoff[k] + m * 2048); } while (0)
#define PG8_LDB(dst, b, h) do { _Pragma("unroll") for (int n = 0; n < 2; ++n) _Pragma("unroll") for (int k = 0; k < 2; ++k) dst[n][k] = *(const LAS bf16x8*)(lds + PG8_SB(b, h) + boff[k] + n * 2048); } while (0)
#define PG8_MMA(ai, bj, At, Bt) do { __builtin_amdgcn_s_setprio(1); _Pragma("unroll") for (int m = 0; m < 4; ++m) _Pragma("unroll") for (int n = 0; n < 2; ++n) _Pragma("unroll") for (int k = 0; k < 2; ++k) \
        acc[ai][bj][m][n] = __builtin_amdgcn_mfma_f32_16x16x32_bf16(Bt[n][k], At[m][k], acc[ai][bj][m][n], 0, 0, 0); __builtin_amdgcn_s_setprio(0); } while (0)
#define PG8_WAIT_V(n) asm volatile("s_waitcnt vmcnt(" #n ")" ::: "memory")
#define PG8_WAIT_L(n) asm volatile("s_waitcnt lgkmcnt(" #n ")" ::: "memory")
#define PG8_BAR __builtin_amdgcn_s_barrier()
#ifndef LWAIT
#define LWAIT 0
#endif
#define PG8_NOWAIT_L do { if (LWAIT) PG8_WAIT_L(0); } while (0)
#define PG8_SCHED __builtin_amdgcn_sched_barrier(0)
    Unit cur, nxt; int ui = 0;
    if (!S.next(0, cur)) return;
    f32x4 acc[2][2][4][2];
#pragma unroll
    for (int a = 0; a < 2; ++a)
#pragma unroll
        for (int b = 0; b < 2; ++b)
#pragma unroll
            for (int m = 0; m < 4; ++m)
#pragma unroll
                for (int n = 0; n < 2; ++n) acc[a][b][m][n] = (f32x4){0.f, 0.f, 0.f, 0.f};
    bf16x8 At[4][2], B0[2][2], B1[2][2];
    const char* cA = cur.A; const char* cB = cur.B;
    PG8_VOFF(vA, 0);
    if constexpr (SP2) {
        PG8_STAGE_X(PG8_SB(0, 0), cB, voffB, B_AUX); PG8_STAGE_X(PG8_SB(0, 1), cB + hstepB, voffB, B_AUX); PG8_STAGE(PG8_SA(0, 0), cA, vA[0]); PG8_STAGE(PG8_SA(0, 1), cA, vA[1]);
        if (wr == 1) PG8_BAR;
        PG8_WAIT_V(2); PG8_BAR;
        PG8_STAGE_X(PG8_SB(1, 0), cB + kstep, voffB, B_AUX); PG8_STAGE(PG8_SA(1, 0), cA + kstep, vA[0]); PG8_STAGE_X(PG8_SB(1, 1), cB + hstepB + kstep, voffB, B_AUX);
        PG8_WAIT_V(6); PG8_BAR;
    } else {
        PG8_STAGE_X(PG8_SB(0, 0), cB, voffB, B_AUX); PG8_STAGE(PG8_SA(0, 0), cA, vA[0]); PG8_STAGE_X(PG8_SB(0, 1), cB + hstepB, voffB, B_AUX); PG8_STAGE(PG8_SA(0, 1), cA, vA[1]);
        if (wr == 1) PG8_BAR;
        PG8_WAIT_V(4); PG8_BAR;
        PG8_STAGE_X(PG8_SB(1, 0), cB + kstep, voffB, B_AUX); PG8_STAGE(PG8_SA(1, 0), cA + kstep, vA[0]); PG8_STAGE_X(PG8_SB(1, 1), cB + hstepB + kstep, voffB, B_AUX);
        PG8_WAIT_V(6); PG8_BAR;
    }
    for (;;) {
        const bool has_next = S.next(ui + 1, nxt);
        const char* nA = has_next ? nxt.A : cA; const char* nB = has_next ? nxt.B : cB;
        if (GATHER && has_next) { PG8_VOFF(vN, ui + 1); }
        else {
#pragma unroll
            for (int h = 0; h < 2; ++h) { vN[h][0] = vA[h][0]; vN[h][1] = vA[h][1]; } }
        for (int t = 0; t < nt; t += 2) {
            const bool last = (t == nt - 2);
            const char* a1 = cA + (size_t)(t + 1) * kstep;
            const char* a2 = last ? nA : cA + (size_t)(t + 2) * kstep; const char* b2 = last ? nB : cB + (size_t)(t + 2) * kstep;
            const char* a3 = a2 + kstep; const char* b3 = b2 + kstep;
            unsigned v2[2][2];
#pragma unroll
            for (int h = 0; h < 2; ++h) { v2[h][0] = (GATHER && last) ? vN[h][0] : vA[h][0]; v2[h][1] = (GATHER && last) ? vN[h][1] : vA[h][1]; }
            if constexpr (SP2) {
            PG8_LDB(B0, 0, 0); PG8_LDB(B1, 0, 1); PG8_SCHED; PG8_LDA(At, 0, 0); PG8_STAGE(PG8_SA(1, 1), a1, vA[1]);
            PG8_WAIT_V(8); PG8_NOWAIT_L; PG8_BAR; PG8_MMA(0, 0, At, B0); PG8_MMA(0, 1, At, B1); PG8_BAR; PG8_SCHED;
#if KLOOP_V == 1
            PG8_LDA(At, 0, 1); PG8_STAGE_X(PG8_SB(0, 0), b2, voffB, B_AUX);
            PG8_WAIT_V(4); PG8_WAIT_L(0); PG8_BAR; PG8_MMA(1, 0, At, B0); PG8_SCHED; PG8_STAGE_X(PG8_SB(0, 1), b2 + hstepB, voffB, B_AUX); PG8_STAGE(PG8_SA(0, 0), a2, v2[0]); PG8_SCHED; PG8_MMA(1, 1, At, B1); PG8_BAR; PG8_SCHED;
#else
            PG8_LDA(At, 0, 1); PG8_STAGE_X(PG8_SB(0, 0), b2, voffB, B_AUX); PG8_STAGE_X(PG8_SB(0, 1), b2 + hstepB, voffB, B_AUX); PG8_STAGE(PG8_SA(0, 0), a2, v2[0]);
            PG8_WAIT_V(8); PG8_NOWAIT_L; PG8_BAR; PG8_MMA(1, 0, At, B0); PG8_MMA(1, 1, At, B1); PG8_BAR; PG8_SCHED;
#endif
            PG8_LDB(B0, 1, 0); PG8_LDB(B1, 1, 1); PG8_SCHED; PG8_LDA(At, 1, 0); PG8_STAGE(PG8_SA(0, 1), a2, v2[1]);
            PG8_WAIT_V(8); PG8_NOWAIT_L; PG8_BAR; PG8_MMA(0, 0, At, B0); PG8_MMA(0, 1, At, B1); PG8_BAR; PG8_SCHED;
#if KLOOP_V == 1
            PG8_LDA(At, 1, 1); PG8_STAGE_X(PG8_SB(1, 0), b3, voffB, B_AUX);
            PG8_WAIT_V(4); PG8_WAIT_L(0); PG8_BAR; PG8_MMA(1, 0, At, B0); PG8_SCHED; PG8_STAGE_X(PG8_SB(1, 1), b3 + hstepB, voffB, B_AUX); PG8_STAGE(PG8_SA(1, 0), a3, v2[0]); PG8_SCHED; PG8_MMA(1, 1, At, B1); PG8_BAR; PG8_SCHED;
#else
            PG8_LDA(At, 1, 1); PG8_STAGE_X(PG8_SB(1, 0), b3, voffB, B_AUX); PG8_STAGE_X(PG8_SB(1, 1), b3 + hstepB, voffB, B_AUX); PG8_STAGE(PG8_SA(1, 0), a3, v2[0]);
            PG8_WAIT_V(8); PG8_NOWAIT_L; PG8_BAR; PG8_MMA(1, 0, At, B0); PG8_MMA(1, 1, At, B1); PG8_BAR; PG8_SCHED;
#endif
            } else {
            PG8_LDB(B0, 0, 0); PG8_SCHED; PG8_LDA(At, 0, 0); PG8_STAGE(PG8_SA(1, 1), a1, vA[1]);
            PG8_WAIT_L(8); PG8_BAR; PG8_WAIT_L(0); PG8_MMA(0, 0, At, B0); PG8_BAR; PG8_SCHED;
            PG8_LDB(B1, 0, 1); PG8_STAGE_X(PG8_SB(0, 0), b2, voffB, B_AUX);
            PG8_BAR; PG8_WAIT_L(0); PG8_MMA(0, 1, At, B1); PG8_BAR;
            PG8_LDA(At, 0, 1); PG8_STAGE(PG8_SA(0, 0), a2, v2[0]);
            PG8_BAR; PG8_WAIT_L(0); PG8_MMA(1, 0, At, B0); PG8_BAR; PG8_SCHED;
            PG8_STAGE_X(PG8_SB(0, 1), b2 + hstepB, voffB, B_AUX);
            PG8_WAIT_V(6); PG8_BAR; PG8_MMA(1, 1, At, B1); PG8_BAR;
            PG8_LDB(B0, 1, 0); PG8_SCHED; PG8_LDA(At, 1, 0); PG8_STAGE(PG8_SA(0, 1), a2, v2[1]);
            PG8_WAIT_L(8); PG8_BAR; PG8_WAIT_L(0); PG8_MMA(0, 0, At, B0); PG8_BAR; PG8_SCHED;
            PG8_LDB(B1, 1, 1); PG8_STAGE_X(PG8_SB(1, 0), b3, voffB, B_AUX);
            PG8_BAR; PG8_WAIT_L(0); PG8_MMA(0, 1, At, B1); PG8_BAR;
            PG8_LDA(At, 1, 1); PG8_STAGE(PG8_SA(1, 0), a3, v2[0]);
            PG8_BAR; PG8_WAIT_L(0); PG8_MMA(1, 0, At, B0); PG8_BAR; PG8_SCHED;
            PG8_STAGE_X(PG8_SB(1, 1), b3 + hstepB, voffB, B_AUX);
            PG8_WAIT_V(6); PG8_BAR; PG8_MMA(1, 1, At, B1); PG8_BAR;
            }
        }
        if constexpr (ALIGN_EPI) { if (wr == 0) PG8_BAR; }
        E(acc, cur, wr, wc, fr, fq, escr);
#if defined(EPI_REP) && EPI_REP
        if constexpr (Epi::IDEM) E(acc, cur, wr, wc, fr, fq, escr);
#endif
        if (!has_next) break;
#pragma unroll
        for (int a = 0; a < 2; ++a)
#pragma unroll
            for (int b = 0; b < 2; ++b)
#pragma unroll
                for (int m = 0; m < 4; ++m)
#pragma unroll
                    for (int n = 0; n < 2; ++n) acc[a][b][m][n] = (f32x4){0.f, 0.f, 0.f, 0.f};
        cur = nxt; cA = nA; cB = nB; ++ui;
#pragma unroll
        for (int h = 0; h < 2; ++h) { vA[h][0] = vN[h][0]; vA[h][1] = vN[h][1]; }
        if constexpr (ALIGN_EPI) { if (wr == 1) PG8_BAR; }
    }
    PG8_WAIT_V(0);
    if constexpr (!ALIGN_EPI) { if (wr == 0) PG8_BAR; }
    PG8_BAR;
#undef PG8_SA
#undef PG8_SB
#undef PG8_STAGE
#undef PG8_STAGE_X
#undef PG8_VOFF
#undef PG8_LDA
#undef PG8_LDB
#undef PG8_MMA
#undef PG8_WAIT_V
#undef PG8_WAIT_L
#undef PG8_BAR
#undef PG8_SCHED
}
}
using pg8::Unit;

struct Args { const float* in[29]; float* out; unsigned char* ws; int ph_lo, ph_hi, wv; };
enum { I_X = 0, I_C, I_CTX, I_CCTX, I_NMIX, I_NFFN, I_NFIN, I_WMOD, I_BMOD, I_WIN, I_WOUT, I_WFNET, I_HCW, I_HCB, I_HW1, I_HB1, I_HW2, I_HB2, I_HW3, I_HB3, I_HWO, I_HFREQ, I_HBIAS, I_HGLB, I_HGNG, I_WR, I_WG, I_WU, I_WDN };

#define WSP(T, off) ((T*)(a.ws + (off)))

__device__ __forceinline__ int mrow_of(int row) { return row < TX ? (row >> 11) : 8; }

__device__ __forceinline__ void transpose_item(const float* src, int ld_src, int k0, int n0, bf16_t* dst, int ldd, int dst_row0, LAS float* scr, int lane) {
    float tv[32];
#pragma unroll
    for (int i = 0; i < 32; ++i) tv[i] = src[(size_t)(k0 + 2 * i + (lane >> 5)) * ld_src + n0 + (lane & 31)];
#pragma unroll
    for (int i = 0; i < 32; ++i) scr[(2 * i + (lane >> 5)) * 33 + (lane & 31)] = tv[i];
    LDS_WAIT(); asm volatile("" ::: "memory");
    const int c = lane & 7;
#pragma unroll
    for (int j = 0; j < 4; ++j) { const int n = (lane >> 3) + 8 * j; const LAS float* s = scr + (8 * c) * 33 + n;
        u32x4 o; o.x = pk2(s[0 * 33], s[1 * 33]); o.y = pk2(s[2 * 33], s[3 * 33]); o.z = pk2(s[4 * 33], s[5 * 33]); o.w = pk2(s[6 * 33], s[7 * 33]);
        *(u32x4*)(dst + (size_t)(dst_row0 + n) * ldd + k0 + 8 * c) = o; }
    LDS_WAIT(); asm volatile("" ::: "memory");
}

#ifndef P0_REP
#define P0_REP 0
#endif
constexpr int BGL_GU0 = 32768, BGL_DN0 = BGL_GU0 + 16384, BGL_IN1 = BGL_DN0 + 32 * 208, BGL_OUT1 = BGL_IN1 + 24 * 64, BGL_GU1 = BGL_OUT1 + 32768, BGL_TOTAL = BGL_GU1 + 16384;
#ifndef TAIL_G1
#define TAIL_G1 18
#define TAIL_G2 18
#define TAIL_E1 14
#define TAIL_E2 8
#endif
#ifndef TAIL_M0
#define TAIL_M0 12
#define TAIL_M1 12
#endif
constexpr int TAILC_G1 = 144 * 8 * TAIL_G1, TAILC_M0 = 128 * 8 * TAIL_M0, TAILC_G2 = 192 * 8 * TAIL_G2, TAILC_E1 = 128 * 8 * TAIL_E1, TAILC_E2 = 128 * 8 * TAIL_E2, TAILC_G1L1 = 32 * 8 * 11, TAILC_M1 = 128 * 8 * TAIL_M1;
constexpr int TS_G1 = 0, TS_M0 = TS_G1 + TAILC_G1, TS_G2 = TS_M0 + TAILC_M0, TS_E1 = TS_G2 + TAILC_G2, TS_E2 = TS_E1 + TAILC_E1, TS_G1L1 = TS_E2 + TAILC_E2, TS_M1 = TS_G1L1 + TAILC_G1L1, TS_END = TS_M1 + TAILC_M1;
constexpr int TAIL_IN_PHASES = TS_END < BGL_TOTAL ? TS_END : BGL_TOTAL;
static_assert(TS_E1 >= BGL_GU0, "layer 0's gate | up weights must be complete before E1(0)");
static_assert(TS_E2 >= BGL_DN0, "layer 0's down weights must be complete before E2(0)");
static_assert(TS_G1L1 >= BGL_IN1, "layer 1's w_in must be complete before G1(1)");
static_assert(TS_M1 >= BGL_OUT1, "layer 1's w_out must be complete before G2(1)");
__device__ __forceinline__ void bgl_tile(const Args& a, int r, LAS float* scr, int lane) {
    if (r < BGL_GU0 || (r >= BGL_OUT1 && r < BGL_GU1)) { const int l = r >= BGL_OUT1 ? 1 : 0; const int r1 = l ? r - BGL_OUT1 : r, up = r1 >> 14, rr = r1 & 16383, e = rr / 1024, q = rr % 1024, kb = q / 32, nb = q % 32, n0 = 32 * nb;
        transpose_item(a.in[up ? I_WU : I_WG] + ((size_t)l * NE + e) * D * FF, FF, 64 * kb, n0, WSP(bf16_t, WS_WGU + l * WGU_BYTES) + (size_t)e * 2 * FF * D, D, 256 * (n0 >> 7) + (n0 & 127) + (up ? 128 : 0), scr, lane); }
    else if (r < BGL_DN0 || r >= BGL_GU1) { const int l = r >= BGL_GU1 ? 1 : 0; const int rr = l ? r - BGL_GU1 : r - BGL_GU0, e = rr / 1024, q = rr % 1024, kb = q / 64, nb = q % 64;
        transpose_item(a.in[I_WDN] + ((size_t)l * NE + e) * FF * D, D, 64 * kb, 32 * nb, WSP(bf16_t, WS_WD + l * WD_BYTES) + (size_t)e * D * FF, FF, 32 * nb, scr, lane); }
    else if (r < BGL_IN1) { const int rr = r - BGL_DN0, kb = rr / 208, nb = rr % 208;
        transpose_item(a.in[I_WIN] + (size_t)D * 7168, 7168, 64 * kb, 512 + 32 * nb, WSP(bf16_t, WS_WIN + WIN_BYTES), D, 1024 + 32 * nb, scr, lane); }
    else { const int rr = r - BGL_IN1, kb = rr / 64, nb = rr % 64;
        transpose_item(a.in[I_WOUT] + (size_t)D * D, D, 512 + 64 * kb, 32 * nb, WSP(bf16_t, WS_WOUT + WOUT_BYTES), D, 32 * nb, scr, lane); }
}
__device__ __forceinline__ void tail_copy(const Args& a, LAS unsigned char* lds, int first, int count, int rank, int nranks) {
    const int tid = opaque(TIDX(a)), lane = tid & 63, wave = __builtin_amdgcn_readfirstlane(tid >> 6);
    LAS float* scr = (LAS float*)(lds + wave * 16384);
    const int last = (first + count < TAIL_IN_PHASES) ? first + count : TAIL_IN_PHASES;
    for (int r = first + rank * 8 + wave; r < last; r += nranks * 8) bgl_tile(a, r, scr, lane);
}
__device__ __forceinline__ void p0_prologue(const Args& a, LAS unsigned char* lds, int bid, int G) {
    const int tid = opaque(TIDX(a)), lane = tid & 63, wave = __builtin_amdgcn_readfirstlane(tid >> 6);
    _Pragma("unroll") for (int p0r_ = 0; p0r_ < 1 + ((P0_REP >> 0) & 1); ++p0r_)
    {
        LAS float* sc = (LAS float*)lds;
        LAS float* red = (LAS float*)(lds + 9 * 2048 * 4);
        const float* cin = a.in[I_C]; const float* cc = a.in[I_CCTX];
        for (int i = tid; i < 9 * 2048; i += 512) { const float v = (i < 8 * 2048) ? cin[i] : cc[i - 8 * 2048]; sc[i] = v * sigmoidf_(v); }
        __syncthreads();
        for (int u = bid; u < 192; u += G) {
            const int l = u / 96, j0 = (u % 96) * 128, kb = wave * 256;
            float acc[9][2];
#pragma unroll
            for (int r = 0; r < 9; ++r) { acc[r][0] = 0.f; acc[r][1] = 0.f; }
            const float* wp = a.in[I_WMOD] + (size_t)l * D * MODW + (size_t)kb * MODW + j0 + 2 * lane;
            for (int k = 0; k < 256; k += 16) {
                f32x2 w[16];
#pragma unroll
                for (int q = 0; q < 16; ++q) w[q] = *(const f32x2*)(wp + (size_t)(k + q) * MODW);
#pragma unroll
                for (int q = 0; q < 16; ++q)
#pragma unroll
                    for (int r = 0; r < 9; ++r) { const float sv = sc[r * 2048 + kb + k + q]; acc[r][0] += sv * w[q].x; acc[r][1] += sv * w[q].y; }
            }
#pragma unroll
            for (int r = 0; r < 9; ++r) *(LAS f32x2*)(red + (wave * 9 + r) * 128 + 2 * lane) = (f32x2){acc[r][0], acc[r][1]};
            __syncthreads();
            for (int i = tid; i < 9 * 128; i += 512) { const int r = i >> 7, cn = i & 127; float s2 = 0.f;
#pragma unroll
                for (int w = 0; w < 8; ++w) s2 += red[(w * 9 + r) * 128 + cn];
                WSP(float, WS_MOD)[(size_t)(l * 9 + r) * MODW + j0 + cn] = s2 + a.in[I_BMOD][l * MODW + j0 + cn]; }
            __syncthreads();
        }
    }
    _Pragma("unroll") for (int p0r_ = 0; p0r_ < 1 + ((P0_REP >> 1) & 1); ++p0r_)
    {
        LAS float* scr = (LAS float*)(lds + wave * 16384);
        const int gw = bid * 8 + wave, NGW = G * 8;
        constexpr int I_IN = 32 * 208, I_OUT = 24 * 64, I_L0 = I_IN + I_OUT;
        const int bg0 = (G == 256) ? TAIL_IN_PHASES : 0;
        const int ntot = I_L0 + (BGL_TOTAL - bg0);
        for (int it = gw; it < ntot; it += NGW) {
            int r = it;
            if (r < I_IN) { const int kb = r / 208, nb = r % 208;
                transpose_item(a.in[I_WIN], 7168, 64 * kb, 512 + 32 * nb, WSP(bf16_t, WS_WIN), D, 1024 + 32 * nb, scr, lane); continue; }
            r -= I_IN;
            if (r < I_OUT) { const int kb = r / 64, nb = r % 64;
                transpose_item(a.in[I_WOUT], D, 512 + 64 * kb, 32 * nb, WSP(bf16_t, WS_WOUT), D, 32 * nb, scr, lane); continue; }
            r -= I_OUT;
            bgl_tile(a, bg0 + r, scr, lane);
        }
        __syncthreads();
    }
    _Pragma("unroll") for (int p0r_ = 0; p0r_ < 1 + ((P0_REP >> 2) & 1); ++p0r_)
    {
        const int gt = bid * 512 + tid, NT = G * 512;
        for (int g = gt; g < LX * (2 * LX / 8); g += NT) { const int tp = g / (2 * LX / 8), k0 = (g % (2 * LX / 8)) * 8; unsigned w[4];
#pragma unroll
            for (int j = 0; j < 8; j += 2) { float v[2];
#pragma unroll
                for (int q = 0; q < 2; ++q) { const int kk = k0 + j + q; const int t = kk & (LX - 1); const float ang = (float)((tp * t) & (LX - 1)) * (2.0f / LX);
                    v[q] = (kk < LX ? cospif(ang) : -sinpif(ang)) * (1.0f / 512.0f); }
                w[j >> 1] = pk2(v[0], v[1]); }
            *(u32x4*)(WSP(bf16_t, WS_DFTX) + (size_t)tp * (2 * LX) + k0) = (u32x4){w[0], w[1], w[2], w[3]}; }
        for (int g = gt; g < LC * (2 * LC / 8); g += NT) { const int tp = g / (2 * LC / 8), k0 = (g % (2 * LC / 8)) * 8; unsigned w[4];
#pragma unroll
            for (int j = 0; j < 8; j += 2) { float v[2];
#pragma unroll
                for (int q = 0; q < 2; ++q) { const int kk = k0 + j + q; const int t = kk & (LC - 1); const float ang = (float)((tp * t) & (LC - 1)) * (2.0f / LC);
                    v[q] = (kk < LC ? cospif(ang) : -sinpif(ang)) * 0.00552427172802f; }
                w[j >> 1] = pk2(v[0], v[1]); }
            *(u32x4*)(WSP(bf16_t, WS_DFTC) + (size_t)tp * (2 * LC) + k0) = (u32x4){w[0], w[1], w[2], w[3]}; }
    }
    _Pragma("unroll") for (int p0r_ = 0; p0r_ < 1 + ((P0_REP >> 3) & 1); ++p0r_)
    {
        LAS float* hz = (LAS float*)lds;
        LAS float* hy = (LAS float*)(lds + 8192);
        LAS float* zf = (LAS float*)(lds + 16384);
        for (int u = bid; u < 2 * 72; u += G) {
            const int l = u / 72, q = u % 72; const bool isx = q < 64; const int L = isx ? LX : LC; const int p0 = (isx ? q : q - 64) * 32;
            __syncthreads();
            for (int idx = tid; idx < 32 * 33; idx += 512) { const int p = idx / 33, j = idx % 33, pos = p0 + p; float v; const float wrev = 2.0f * (float)pos / (float)L;
                if (j == 0) v = (float)pos / (float)(L - 1);
                else { const int bi = (j - 1) & 15; const float band = 1e-4f + (float)bi * ((15.0f - 1e-4f) / 15.0f); v = (j <= 16) ? cospif(band * wrev) : -sinpif(band * wrev); }
                zf[p * 36 + j] = v; }
            __syncthreads();
            const int j = tid & 63, pg = tid >> 6;
            { float s4[4]; const float bb = a.in[I_HB1][l * 64 + j]; const float* w1 = a.in[I_HW1] + l * 33 * 64;
#pragma unroll
                for (int qq = 0; qq < 4; ++qq) s4[qq] = bb;
                for (int m = 0; m < 33; ++m) { const float w = w1[m * 64 + j];
#pragma unroll
                    for (int qq = 0; qq < 4; ++qq) s4[qq] += zf[(4 * pg + qq) * 36 + m] * w; }
                const float fr = a.in[I_HFREQ][(l * 3 + 0) * 64 + j] * 0.318309886184f;
#pragma unroll
                for (int qq = 0; qq < 4; ++qq) hz[(4 * pg + qq) * 64 + j] = sinpif(fr * s4[qq]); }
            __syncthreads();
            { float s4[4]; const float bb = a.in[I_HB2][l * 64 + j]; const float* w2 = a.in[I_HW2] + l * 64 * 64;
#pragma unroll
                for (int qq = 0; qq < 4; ++qq) s4[qq] = bb;
                for (int m = 0; m < 64; ++m) { const float w = w2[m * 64 + j];
#pragma unroll
                    for (int qq = 0; qq < 4; ++qq) s4[qq] += hz[(4 * pg + qq) * 64 + m] * w; }
                const float fr = a.in[I_HFREQ][(l * 3 + 1) * 64 + j] * 0.318309886184f;
#pragma unroll
                for (int qq = 0; qq < 4; ++qq) hy[(4 * pg + qq) * 64 + j] = sinpif(fr * s4[qq]); }
            __syncthreads();
            { float s4[4]; const float bb = a.in[I_HB3][l * 64 + j]; const float* w3 = a.in[I_HW3] + l * 64 * 64;
#pragma unroll
                for (int qq = 0; qq < 4; ++qq) s4[qq] = bb;
                for (int m = 0; m < 64; ++m) { const float w = w3[m * 64 + j];
#pragma unroll
                    for (int qq = 0; qq < 4; ++qq) s4[qq] += hy[(4 * pg + qq) * 64 + m] * w; }
                const float fr = a.in[I_HFREQ][(l * 3 + 2) * 64 + j] * 0.318309886184f;
#pragma unroll
                for (int qq = 0; qq < 4; ++qq) hz[(4 * pg + qq) * 64 + j] = sinpif(fr * s4[qq]); }
            __syncthreads();
            const float* wo = a.in[I_HWO] + l * 64 * 1024;
            bf16_t* kr = isx ? WSP(bf16_t, WS_KRX) + (size_t)l * 512 * KRX_LD : WSP(bf16_t, WS_KRC) + (size_t)l * 512 * KRC_LD;
            const int ld = isx ? KRX_LD : KRC_LD;
            for (int h = 0; h < 2; ++h) {
                const int n = tid + 512 * h, c = n & 511, dir = n >> 9;
                float w[64];
#pragma unroll
                for (int m = 0; m < 64; ++m) w[m] = wo[m * 1024 + n];
                const float adelta = fabsf(-3.07011346f + (float)c * ((-15.3505673f + 3.07011346f) / 511.0f));
                for (int pp = 0; pp < 32; ++pp) { float acc = 0.f;
#pragma unroll
                    for (int m4 = 0; m4 < 16; ++m4) { const f32x4 hv = *(const LAS f32x4*)(hz + pp * 64 + 4 * m4); acc += hv.x * w[4 * m4] + hv.y * w[4 * m4 + 1] + hv.z * w[4 * m4 + 2] + hv.w * w[4 * m4 + 3]; }
                    const int ps = p0 + pp; const float tn = (float)ps / (float)(L - 1); const float v = acc * __expf(-tn * adelta);
                    if (dir == 0) kr[(size_t)c * ld + (L - ps)] = (bf16_t)f2bf(v);
                    else if (ps >= 1) kr[(size_t)c * ld + (L + ps)] = (bf16_t)f2bf(v); }
                if (p0 == 0 && dir == 0) { kr[(size_t)c * ld] = 0;
#pragma unroll
                    for (int z = 0; z < 8; ++z) kr[(size_t)c * ld + 2 * L + z] = 0; }
            }
        }
        __syncthreads();
    }
    _Pragma("unroll") for (int p0r_ = 0; p0r_ < 1 + ((P0_REP >> 4) & 1); ++p0r_)
    {
        constexpr int TS = 272;
        LAS unsigned char* Tt = lds;
        LAS unsigned char* Bt = lds + 256 * TS;
        const int lr = lane & 15, lq = lane >> 4;
        __syncthreads();
        for (int i = tid; i < 256 * 64; i += 512) { const int np = i >> 6, c = (i & 63) * 2; const int cs = np >> 7, cp = np & 127;
            const float t0 = cospif((float)((c * cp + (cs ? 96 : 0)) & 127) * (1.0f / 64.0f)), t1 = cospif((float)(((c + 1) * cp + (cs ? 96 : 0)) & 127) * (1.0f / 64.0f));
            *(LAS unsigned*)(Tt + np * TS + c * 2) = pk2(t0, t1); }
        for (int u = bid; u < 2 * 256; u += G) {
            const int l = u >> 8, g = (u >> 6) & 3, k0 = (u & 63) * 32;
            __syncthreads();
            { const int kk = tid >> 4, c8 = tid & 15; const float* src = a.in[I_WIN] + (size_t)l * D * 7168 + (size_t)(k0 + kk) * 7168 + g * 128 + 8 * c8;
              const f32x4 v0 = *(const f32x4*)src, v1 = *(const f32x4*)(src + 4);
              *(LAS u32x4*)(Bt + kk * TS + c8 * 16) = (u32x4){pk2(v0.x, v0.y), pk2(v0.z, v0.w), pk2(v1.x, v1.y), pk2(v1.z, v1.w)}; }
            __syncthreads();
            f32x4 acc[2][2];
#pragma unroll
            for (int kt = 0; kt < 2; ++kt) { acc[kt][0] = (f32x4){0.f, 0.f, 0.f, 0.f}; acc[kt][1] = acc[kt][0]; }
#pragma unroll
            for (int ks = 0; ks < 4; ++ks) { bf16x8 af[2], bf[2];
#pragma unroll
                for (int kt = 0; kt < 2; ++kt) af[kt] = *(const LAS bf16x8*)(Bt + (16 * kt + lr) * TS + ks * 64 + lq * 16);
#pragma unroll
                for (int nt = 0; nt < 2; ++nt) bf[nt] = *(const LAS bf16x8*)(Tt + (16 * (2 * wave + nt) + lr) * TS + ks * 64 + lq * 16);
#pragma unroll
                for (int kt = 0; kt < 2; ++kt)
#pragma unroll
                    for (int nt = 0; nt < 2; ++nt) acc[kt][nt] = __builtin_amdgcn_mfma_f32_16x16x32_bf16(af[kt], bf[nt], acc[kt][nt], 0, 0, 0); }
#pragma unroll
            for (int kt = 0; kt < 2; ++kt)
#pragma unroll
                for (int nt = 0; nt < 2; ++nt) { const int np = 16 * (2 * wave + nt) + lr, cs = np >> 7, cp = np & 127; const f32x4 v = acc[kt][nt];
                    *(u32x2*)(WSP(bf16_t, WS_WIN + l * WIN_BYTES) + (size_t)(cs * 512 + g * 128 + cp) * D + k0 + 16 * kt + 4 * lq) = (u32x2){pk2(v.x, v.y), pk2(v.z, v.w)}; }
        }
        __syncthreads();
    }
    _Pragma("unroll") for (int p0r_ = 0; p0r_ < 1 + ((P0_REP >> 5) & 1); ++p0r_)
    {
        constexpr int FS = 80;
        LAS unsigned char* At = lds;
        LAS unsigned char* Bt = lds + 64 * FS;
        const int lr = lane & 15, lq = lane >> 4, nt = wave & 3, ih = wave >> 2;
        for (int u = bid; u < 2 * 128; u += G) {
            const int l = u >> 7, n0 = ((u >> 2) & 31) * 64, i0 = (u & 3) * 128;
            f32x4 acc[4];
#pragma unroll
            for (int it = 0; it < 4; ++it) acc[it] = (f32x4){0.f, 0.f, 0.f, 0.f};
            for (int j0 = 0; j0 < 512; j0 += 32) {
                __syncthreads();
#pragma unroll
                for (int q = 0; q < 4; ++q) { const int idx = tid + 512 * q, jj = idx >> 6, nn = idx & 63;
                    *(LAS bf16_t*)(At + nn * FS + jj * 2) = (bf16_t)f2bf(a.in[I_WOUT][(size_t)l * D * D + (size_t)(j0 + jj) * D + n0 + nn]); }
                { const int ii = tid >> 2, c8 = tid & 3; const float* src = a.in[I_WFNET] + (size_t)l * 512 * 512 + (size_t)(i0 + ii) * 512 + j0 + 8 * c8;
                  const f32x4 v0 = *(const f32x4*)src, v1 = *(const f32x4*)(src + 4);
                  *(LAS u32x4*)(Bt + ii * FS + c8 * 16) = (u32x4){pk2(v0.x, v0.y), pk2(v0.z, v0.w), pk2(v1.x, v1.y), pk2(v1.z, v1.w)}; }
                __syncthreads();
                const bf16x8 bfr = *(const LAS bf16x8*)(At + (16 * nt + lr) * FS + lq * 16);
#pragma unroll
                for (int it = 0; it < 4; ++it) { const bf16x8 afr = *(const LAS bf16x8*)(Bt + (64 * ih + 16 * it + lr) * FS + lq * 16);
                    acc[it] = __builtin_amdgcn_mfma_f32_16x16x32_bf16(afr, bfr, acc[it], 0, 0, 0); }
            }
#pragma unroll
            for (int it = 0; it < 4; ++it) { const f32x4 v = acc[it];
                *(u32x2*)(WSP(bf16_t, WS_WOUT + l * WOUT_BYTES) + (size_t)(n0 + 16 * nt + lr) * D + i0 + 64 * ih + 16 * it + 4 * lq) = (u32x2){pk2(v.x, v.y), pk2(v.z, v.w)}; }
        }
        __syncthreads();
    }
}

template <int MODE>
__device__ __forceinline__ void norm_pass(const Args& a, int bid, int G) {
    const int tid = opaque(TIDX(a)), lane = tid & 63, wave = __builtin_amdgcn_readfirstlane(tid >> 6);
    const int gw = bid * 8 + wave, NGW = G * 8;
    const int nrows = (MODE == 2) ? TX : TT;
    const int rpw = (nrows + NGW - 1) / NGW;
    const int r0 = gw * rpw, r1 = (r0 + rpw < nrows) ? r0 + rpw : nrows;
    if (r0 >= r1) return;
    const float* modb = WSP(float, WS_MOD);
    f32x4 ca[4][2], cb[4][2], cg[4][2];
    int cur_mr = -1;
    f32x4 xn[4][2]; u32x4 xnb[4]; int sln = -1;
    auto load_row = [&](int row) {
        if (MODE == 0) { const float* src = (row < TX ? a.in[I_X] + (size_t)row * D : a.in[I_CTX] + (size_t)(row - TX) * D);
#pragma unroll
            for (int j = 0; j < 4; ++j)
#pragma unroll
                for (int h = 0; h < 2; ++h) xn[j][h] = *(const f32x4*)(src + 8 * lane + 512 * j + 4 * h); }
        else { const bf16_t* src = WSP(bf16_t, WS_XCUR) + (size_t)row * D;
#pragma unroll
            for (int j = 0; j < 4; ++j) xnb[j] = *(const u32x4*)(src + 8 * lane + 512 * j);
            sln = WSP(int, WS_SLOT)[(size_t)row * 16 + (lane & 15)]; } };
    load_row(r0);
    u32x4 yp[2][4]; int pe0 = -1, pe1 = -1;
    auto issue_yp = [&](int slots) {
        unsigned long long m2 = __builtin_amdgcn_ballot_w64(slots >= 0) & 0xFFFFull; pe0 = -1; pe1 = -1;
        if (m2) { pe0 = __builtin_ctzll(m2); m2 &= m2 - 1; const bf16_t* yr = WSP(bf16_t, WS_Y) + ((size_t)pe0 * ROWS_E + __builtin_amdgcn_readlane(slots, pe0)) * D;
#pragma unroll
            for (int j = 0; j < 4; ++j) yp[0][j] = *(const u32x4*)(yr + 8 * lane + 512 * j); }
        if (m2) { pe1 = __builtin_ctzll(m2); const bf16_t* yr = WSP(bf16_t, WS_Y) + ((size_t)pe1 * ROWS_E + __builtin_amdgcn_readlane(slots, pe1)) * D;
#pragma unroll
            for (int j = 0; j < 4; ++j) yp[1][j] = *(const u32x4*)(yr + 8 * lane + 512 * j); } };
    if (MODE >= 1) issue_yp(sln);
    for (int row = r0; row < r1; ++row) {
        f32x4 x[4][2]; const int slv = sln; const int ce0 = pe0, ce1 = pe1;
#pragma unroll
        for (int j = 0; j < 4; ++j) {
            if (MODE == 0) { x[j][0] = xn[j][0]; x[j][1] = xn[j][1]; }
            else { const u32x4 w = xnb[j]; x[j][0] = (f32x4){bflo(w.x), bfhi(w.x), bflo(w.y), bfhi(w.y)}; x[j][1] = (f32x4){bflo(w.z), bfhi(w.z), bflo(w.w), bfhi(w.w)}; } }
        if (row + 1 < r1) load_row(row + 1);
        const int mr = mrow_of(row);
        if (mr != cur_mr) { cur_mr = mr;
#pragma unroll
            for (int j = 0; j < 4; ++j)
#pragma unroll
                for (int h = 0; h < 2; ++h) { const int d = 8 * lane + 512 * j + 4 * h;
                    if (MODE == 2) { ca[j][h] = *(const f32x4*)(a.in[I_NFIN] + d); cb[j][h] = (f32x4){0.f, 0.f, 0.f, 0.f}; }
                    else { const int l = MODE; const f32x4 g = *(const f32x4*)(a.in[I_NMIX] + l * D + d); const f32x4 sc = *(const f32x4*)(modb + (size_t)(l * 9 + mr) * MODW + D + d);
                        ca[j][h] = g * (1.0f + sc); cb[j][h] = *(const f32x4*)(modb + (size_t)(l * 9 + mr) * MODW + d); }
                    if (MODE >= 1) cg[j][h] = *(const f32x4*)(modb + (size_t)((MODE - 1) * 9 + mr) * MODW + 5 * D + d); } }
        if (MODE >= 1) {
#pragma unroll
            for (int q = 0; q < 2; ++q) if ((q ? ce1 : ce0) >= 0) {
#pragma unroll
                for (int j = 0; j < 4; ++j) { const u32x4 w = yp[q][j];
                    x[j][0] += cg[j][0] * (f32x4){bflo(w.x), bfhi(w.x), bflo(w.y), bfhi(w.y)}; x[j][1] += cg[j][1] * (f32x4){bflo(w.z), bfhi(w.z), bflo(w.w), bfhi(w.w)}; } }
            unsigned long long msk = __builtin_amdgcn_ballot_w64(slv >= 0) & 0xFFFFull;
            if (msk) msk &= msk - 1;
            if (msk) msk &= msk - 1;
            while (msk) {
                const int e = __builtin_ctzll(msk); msk &= msk - 1; const int sr = __builtin_amdgcn_readlane(slv, e);
                const bf16_t* yr = WSP(bf16_t, WS_Y) + ((size_t)e * ROWS_E + sr) * D;
                u32x4 yv[4];
#pragma unroll
                for (int j = 0; j < 4; ++j) yv[j] = *(const u32x4*)(yr + 8 * lane + 512 * j);
#pragma unroll
                for (int j = 0; j < 4; ++j) { const u32x4 w = yv[j];
                    x[j][0] += cg[j][0] * (f32x4){bflo(w.x), bfhi(w.x), bflo(w.y), bfhi(w.y)}; x[j][1] += cg[j][1] * (f32x4){bflo(w.z), bfhi(w.z), bflo(w.w), bfhi(w.w)}; }
            }
            if (row + 1 < r1) issue_yp(sln);
            if (MODE == 1) {
                bf16_t* dstx = WSP(bf16_t, WS_XCUR) + (size_t)row * D;
#pragma unroll
                for (int j = 0; j < 4; ++j) *(u32x4*)(dstx + 8 * lane + 512 * j) = (u32x4){pk2(x[j][0].x, x[j][0].y), pk2(x[j][0].z, x[j][0].w), pk2(x[j][1].x, x[j][1].y), pk2(x[j][1].z, x[j][1].w)};
            }
        }
        float ss = 0.f;
#pragma unroll
        for (int j = 0; j < 4; ++j)
#pragma unroll
            for (int h = 0; h < 2; ++h) ss += (x[j][h].x * x[j][h].x + x[j][h].y * x[j][h].y) + (x[j][h].z * x[j][h].z + x[j][h].w * x[j][h].w);
        const float rstd = 1.0f / sqrtf(wave_sum(ss, lane) * (1.0f / D) + EPS);
        if (MODE == 2) {
            float* o = a.out + (size_t)row * D;
#pragma unroll
            for (int j = 0; j < 4; ++j)
#pragma unroll
                for (int h = 0; h < 2; ++h) *(f32x4*)(o + 8 * lane + 512 * j + 4 * h) = x[j][h] * rstd * ca[j][h];
        } else {
            bf16_t* o = WSP(bf16_t, WS_XM) + (size_t)row * D;
#pragma unroll
            for (int j = 0; j < 4; ++j) { const f32x4 v0 = x[j][0] * rstd * ca[j][0] + cb[j][0], v1 = x[j][1] * rstd * ca[j][1] + cb[j][1];
                *(u32x4*)(o + 8 * lane + 512 * j) = (u32x4){pk2(v0.x, v0.y), pk2(v0.z, v0.w), pk2(v1.x, v1.y), pk2(v1.z, v1.w)}; }
        }
    }
}

__device__ __forceinline__ void n2_pass(const Args& a, LAS unsigned char* lds, int l, int bid, int G) {
    const int tid = opaque(TIDX(a)), lane = tid & 63, wave = __builtin_amdgcn_readfirstlane(tid >> 6);
    LAS float* wrT = (LAS float*)lds;
    const float* wr = a.in[I_WR] + (size_t)l * D * NE;
    for (int d = tid; d < D; d += 512) {
        const f32x4 r0 = *(const f32x4*)(wr + d * 16), r1 = *(const f32x4*)(wr + d * 16 + 4), r2 = *(const f32x4*)(wr + d * 16 + 8), r3 = *(const f32x4*)(wr + d * 16 + 12);
        const float rv[16] = {r0.x, r0.y, r0.z, r0.w, r1.x, r1.y, r1.z, r1.w, r2.x, r2.y, r2.z, r2.w, r3.x, r3.y, r3.z, r3.w};
#pragma unroll
        for (int e = 0; e < 16; ++e) wrT[e * D + d] = rv[e]; }
    __syncthreads();
    const int npairs = ((l == 0) ? TT : TX) / 2;
    const int gw = bid * 8 + wave, NGW = G * 8;
    const int ppw = (npairs + NGW - 1) / NGW;
    const int p0 = gw * ppw, p1 = (p0 + ppw < npairs) ? p0 + ppw : npairs;
    const float* modb = WSP(float, WS_MOD);
    const bool b5 = (lane & 32) != 0, b4 = (lane & 16) != 0, b3 = (lane & 8) != 0, b2 = (lane & 4) != 0, b1 = (lane & 2) != 0;
    f32x4 ca[4][2], cb[4][2]; int cur_mr = -1;
    u32x4 xn[2][4];
    if (p0 < p1) {
#pragma unroll
        for (int r = 0; r < 2; ++r) { const bf16_t* src = WSP(bf16_t, WS_XCUR) + (size_t)(2 * p0 + r) * D;
#pragma unroll
            for (int j = 0; j < 4; ++j) xn[r][j] = *(const u32x4*)(src + 8 * lane + 512 * j); } }
    for (int p = p0; p < p1; ++p) {
        const int row0 = 2 * p, mr = mrow_of(row0);
        f32x4 xv[2][4][2];
#pragma unroll
        for (int r = 0; r < 2; ++r)
#pragma unroll
            for (int j = 0; j < 4; ++j) { const u32x4 w = xn[r][j]; xv[r][j][0] = (f32x4){bflo(w.x), bfhi(w.x), bflo(w.y), bfhi(w.y)}; xv[r][j][1] = (f32x4){bflo(w.z), bfhi(w.z), bflo(w.w), bfhi(w.w)}; }
        if (p + 1 < p1) {
#pragma unroll
            for (int r = 0; r < 2; ++r) { const bf16_t* src = WSP(bf16_t, WS_XCUR) + (size_t)(row0 + 2 + r) * D;
#pragma unroll
                for (int j = 0; j < 4; ++j) xn[r][j] = *(const u32x4*)(src + 8 * lane + 512 * j); } }
        if (mr != cur_mr) { cur_mr = mr;
#pragma unroll
            for (int j = 0; j < 4; ++j)
#pragma unroll
                for (int h = 0; h < 2; ++h) { const int d = 8 * lane + 512 * j + 4 * h;
                    const f32x4 g = *(const f32x4*)(a.in[I_NFFN] + l * D + d); const f32x4 sc = *(const f32x4*)(modb + (size_t)(l * 9 + mr) * MODW + 4 * D + d);
                    ca[j][h] = g * (1.0f + sc); cb[j][h] = *(const f32x4*)(modb + (size_t)(l * 9 + mr) * MODW + 3 * D + d); } }
#pragma unroll
        for (int r = 0; r < 2; ++r) {
            float ss = 0.f;
#pragma unroll
            for (int j = 0; j < 4; ++j)
#pragma unroll
                for (int h = 0; h < 2; ++h) { const f32x4 x = xv[r][j][h]; ss += (x.x * x.x + x.y * x.y) + (x.z * x.z + x.w * x.w); }
            const float rstd = 1.0f / sqrtf(wave_sum(ss, lane) * (1.0f / D) + EPS);
            bf16_t* o = WSP(bf16_t, WS_XM) + (size_t)(row0 + r) * D;
#pragma unroll
            for (int j = 0; j < 4; ++j) {
#pragma unroll
                for (int h = 0; h < 2; ++h) xv[r][j][h] = xv[r][j][h] * rstd * ca[j][h] + cb[j][h];
                const f32x4 v0 = xv[r][j][0], v1 = xv[r][j][1];
                *(u32x4*)(o + 8 * lane + 512 * j) = (u32x4){pk2(v0.x, v0.y), pk2(v0.z, v0.w), pk2(v1.x, v1.y), pk2(v1.z, v1.w)}; }
        }
        float v32[32];
#pragma unroll
        for (int e = 0; e < 16; ++e) { f32x2 a0 = {0.f, 0.f}, a1 = {0.f, 0.f};
#pragma unroll
            for (int j = 0; j < 4; ++j)
#pragma unroll
                for (int h = 0; h < 2; ++h) { const f32x4 w = *(const LAS f32x4*)(wrT + e * D + 8 * lane + 512 * j + 4 * h);
                    const f32x2 wl = {w.x, w.y}, wh = {w.z, w.w};
                    a0 += (f32x2){xv[0][j][h].x, xv[0][j][h].y} * wl; a0 += (f32x2){xv[0][j][h].z, xv[0][j][h].w} * wh;
                    a1 += (f32x2){xv[1][j][h].x, xv[1][j][h].y} * wl; a1 += (f32x2){xv[1][j][h].z, xv[1][j][h].w} * wh; }
            v32[e] = a0.x + a0.y; v32[16 + e] = a1.x + a1.y; asm volatile("" ::: "memory"); }
        float v16[16], v8[8], v4[4], v2[2];
#pragma unroll
        for (int i = 0; i < 16; ++i) { const float mine = b5 ? v32[16 + i] : v32[i], send = b5 ? v32[i] : v32[16 + i]; v16[i] = mine + shx(send, 32, lane); }
#pragma unroll
        for (int i = 0; i < 8; ++i) { const float mine = b4 ? v16[8 + i] : v16[i], send = b4 ? v16[i] : v16[8 + i]; v8[i] = mine + shx(send, 16, lane); }
#pragma unroll
        for (int i = 0; i < 4; ++i) { const float mine = b3 ? v8[4 + i] : v8[i], send = b3 ? v8[i] : v8[4 + i]; v4[i] = mine + shx(send, 8, lane); }
#pragma unroll
        for (int i = 0; i < 2; ++i) { const float mine = b2 ? v4[2 + i] : v4[i], send = b2 ? v4[i] : v4[2 + i]; v2[i] = mine + shx(send, 4, lane); }
        float lgv;
        { const float mine = b1 ? v2[1] : v2[0], send = b1 ? v2[0] : v2[1]; lgv = mine + shx(send, 2, lane); }
        lgv += shx(lgv, 1, lane);
        float mx = lgv;
        mx = fmaxf(mx, shx(mx, 2, lane)); mx = fmaxf(mx, shx(mx, 4, lane)); mx = fmaxf(mx, shx(mx, 8, lane)); mx = fmaxf(mx, shx(mx, 16, lane));
        const float pe = __expf(lgv - mx); float den = pe;
        den += shx(den, 2, lane); den += shx(den, 4, lane); den += shx(den, 8, lane); den += shx(den, 16, lane);
        if ((lane & 1) == 0) { const int ln = opaque(lane); const int row = row0 + (ln >> 5), e = (ln >> 1) & 15; float* dst;
            if (row < TX) dst = WSP(float, WS_AFF) + ((size_t)(row >> 11) * 16 + e) * LX + (row & (LX - 1));
            else { const int rc = row - TX; dst = WSP(float, WS_AFF) + (size_t)NB * 16 * LX + ((size_t)(rc >> 8) * 16 + e) * LC + (rc & (LC - 1)); }
            *dst = pe / den; }
    }
    __syncthreads();
}

__device__ __forceinline__ void topk_pass(const Args& a, LAS unsigned char* lds, int l, int bid, int G) {
    const int tid = opaque(TIDX(a));
    LAS unsigned long long* key = (LAS unsigned long long*)lds;
    const int nunits = (l == 0) ? 256 : 128;
    for (int u = bid; u < nunits; u += G) {
        const bool isx = u < 128; const int b = (u & 127) >> 4, e = u & 15; const int L = isx ? LX : LC, cap = isx ? CAPX : CAPC;
        const float* src = isx ? WSP(float, WS_AFF) + ((size_t)b * 16 + e) * LX : WSP(float, WS_AFF) + (size_t)NB * 16 * LX + ((size_t)b * 16 + e) * LC;
        __syncthreads();
        for (int i = tid; i < L; i += 512) key[i] = ((unsigned long long)__builtin_bit_cast(unsigned, src[i]) << 32) | (unsigned long long)(0xFFFFFFFFu - (unsigned)i);
        const int lane_ = tid & 63, wave_ = __builtin_amdgcn_readfirstlane(tid >> 6);
        __syncthreads();
        for (int k = 2; k <= L; k <<= 1) {
            int j = k >> 1;
            for (; j >= 256; j >>= 1) {
                __syncthreads();
                for (int i = tid; i < L / 2; i += 512) {
                    const int idx = 2 * i - (i & (j - 1)), ixj = idx | j;
                    const unsigned long long x = key[idx], y = key[ixj];
                    const bool desc = (idx & k) == 0;
                    if ((x < y) == desc) { key[idx] = y; key[ixj] = x; }
                }
                if (j == 256) __syncthreads();
            }
            if (256 * wave_ < L) {
                for (; j > 0; j >>= 1) {
#pragma unroll
                    for (int q = 0; q < 2; ++q) { const int i = 128 * wave_ + lane_ + 64 * q;
                        const int idx = 2 * i - (i & (j - 1)), ixj = idx | j;
                        const unsigned long long x = key[idx], y = key[ixj];
                        const bool desc = (idx & k) == 0;
                        if ((x < y) == desc) { key[idx] = y; key[ixj] = x; } }
                    asm volatile("s_waitcnt lgkmcnt(0)" ::: "memory");
                }
            }
        }
        __syncthreads();
        for (int p = tid; p < L; p += 512) {
            const unsigned long long kv = key[p]; const int t = (int)(0xFFFFFFFFu - (unsigned)kv);
            const int row = isx ? b * LX + t : TX + b * LC + t;
            int slot = -1;
            if (p < cap) { slot = isx ? b * CAPX + p : NB * CAPX + b * CAPC + p;
                WSP(int, WS_IDX)[e * ROWS_E + slot] = row; WSP(float, WS_GATE)[e * ROWS_E + slot] = __builtin_bit_cast(float, (unsigned)(kv >> 32)); }
            WSP(int, WS_SLOT)[(size_t)row * 16 + e] = slot;
        }
    }
    __syncthreads();
}

__device__ __forceinline__ void gather_pass(const Args& a, int l, int bid, int G) {
    const int tid = opaque(TIDX(a)), lane = tid & 63, wave = __builtin_amdgcn_readfirstlane(tid >> 6);
    const int gw = bid * 8 + wave, NGW = G * 8; const int rows_e = (l == 0) ? ROWS_E : NB * CAPX;
    for (int it = gw; it < NE * rows_e; it += NGW) { const int e = it / rows_e, s = it % rows_e;
        const int row = WSP(int, WS_IDX)[e * ROWS_E + s];
        const u32x4* src = (const u32x4*)(WSP(bf16_t, WS_XM) + (size_t)row * D); u32x4* dst = (u32x4*)(WSP(bf16_t, WS_XS) + ((size_t)e * ROWS_E + s) * D);
#pragma unroll
        for (int j = 0; j < 4; ++j) dst[lane + 64 * j] = src[lane + 64 * j]; }
}

__device__ __forceinline__ void hgrn_out_pass(const Args& a, LAS unsigned char* lds, int l, int bid, int G) {
    const int tid = opaque(TIDX(a)), lane = tid & 63, wave = __builtin_amdgcn_readfirstlane(tid >> 6);
    const int gw = bid * 8 + wave, NGW = G * 8; const int nrows = (l == 0) ? TT : TX;
    {
        constexpr int TP = 132;
        LAS unsigned char* tile = lds + wave * (64 * TP);
        const int njobs = (l == 0) ? 2048 + 256 : 2048;
        for (int j = gw; j < njobs; j += NGW) {
            const bool isx = j < 2048; const int jj = isx ? j : j - 2048; const int L = isx ? LX : LC;
            const int tb = isx ? (jj & 31) : (jj & 3), cg = isx ? ((jj >> 5) & 7) : ((jj >> 2) & 7), b = isx ? (jj >> 8) : (jj >> 5);
            const bf16_t* src = (isx ? WSP(bf16_t, WS_HTX) : WSP(bf16_t, WS_HTC)) + ((size_t)b * 1536 + cg * 64) * L + tb * 64;
            u32x4 v[8];
#pragma unroll
            for (int i = 0; i < 8; ++i) v[i] = *(const u32x4*)(src + (size_t)((lane >> 3) + 8 * i) * L + (lane & 7) * 8);
#pragma unroll
            for (int i = 0; i < 8; ++i) { const int c = (lane >> 3) + 8 * i; LAS unsigned char* w = tile + ((lane & 7) * 8) * TP + c * 2; const unsigned ww[4] = {v[i].x, v[i].y, v[i].z, v[i].w};
#pragma unroll
                for (int k = 0; k < 4; ++k) { *(LAS unsigned short*)(w + (2 * k) * TP) = (unsigned short)(ww[k] & 0xffffu); *(LAS unsigned short*)(w + (2 * k + 1) * TP) = (unsigned short)(ww[k] >> 16); } }
            asm volatile("" ::: "memory");
            bf16_t* dst = WSP(bf16_t, WS_MIX) + (size_t)((isx ? b * LX : TX + b * LC) + tb * 64) * D + 512 + cg * 64;
#pragma unroll
            for (int i = 0; i < 8; ++i) { const int t = (lane >> 3) + 8 * i; const LAS unsigned* r = (const LAS unsigned*)(tile + t * TP + (lane & 7) * 16);
                *(u32x4*)(dst + (size_t)t * D + (lane & 7) * 8) = (u32x4){r[0], r[1], r[2], r[3]}; }
            asm volatile("" ::: "memory");
        }
    }
    float gn[16];
#pragma unroll
    for (int k = 0; k < 16; ++k) gn[k] = a.in[I_HGNG][l * 1024 + 16 * lane + k];
    u32x4 nf[2], nb[2], ng[2];
    auto load_row = [&](int row) { const u32x4* pf = (const u32x4*)(WSP(bf16_t, WS_OF) + (size_t)row * 1024 + 16 * lane); const u32x4* pb = (const u32x4*)(WSP(bf16_t, WS_OB) + (size_t)row * 1024 + 16 * lane);
        const u32x4* pg = (const u32x4*)(WSP(bf16_t, WS_HG) + (size_t)row * HGW + 4096 + 16 * lane);
        nf[0] = pf[0]; nf[1] = pf[1]; nb[0] = pb[0]; nb[1] = pb[1]; ng[0] = pg[0]; ng[1] = pg[1]; };
    if (gw < nrows) load_row(gw);
    for (int row = gw; row < nrows; row += NGW) {
        float o[16], g[16]; float ss = 0.f;
#pragma unroll
        for (int q = 0; q < 2; ++q) { const u32x4 f = nf[q], bb = nb[q], gg = ng[q]; const unsigned fw[4] = {f.x, f.y, f.z, f.w}, bw[4] = {bb.x, bb.y, bb.z, bb.w}, gw4[4] = {gg.x, gg.y, gg.z, gg.w};
#pragma unroll
            for (int k = 0; k < 4; ++k) { o[8 * q + 2 * k] = bflo(fw[k]) + bflo(bw[k]); o[8 * q + 2 * k + 1] = bfhi(fw[k]) + bfhi(bw[k]); g[8 * q + 2 * k] = bflo(gw4[k]); g[8 * q + 2 * k + 1] = bfhi(gw4[k]); } }
        if (row + NGW < nrows) load_row(row + NGW);
#pragma unroll
        for (int k = 0; k < 16; ++k) ss += o[k] * o[k];
        ss += shx(ss, 1, lane); ss += shx(ss, 2, lane); ss += shx(ss, 4, lane);
        const float rstd = 1.0f / sqrtf(ss * (1.0f / 128.0f) + EPS);
        unsigned w[8];
#pragma unroll
        for (int k = 0; k < 8; ++k) { const float y0 = o[2 * k] * rstd * gn[2 * k] * (g[2 * k] * sigmoidf_(g[2 * k])), y1 = o[2 * k + 1] * rstd * gn[2 * k + 1] * (g[2 * k + 1] * sigmoidf_(g[2 * k + 1])); w[k] = pk2(y0, y1); }
        u32x4* dst = (u32x4*)(WSP(bf16_t, WS_MIX) + (size_t)row * D + 1024 + 16 * lane);
        dst[0] = (u32x4){w[0], w[1], w[2], w[3]}; dst[1] = (u32x4){w[4], w[5], w[6], w[7]};
    }
}

typedef f32x4 AccT[2][2][4][2];
using pg8::EPI_RS;
__device__ __forceinline__ void epi_rows64(LAS unsigned char* scr, int fr, int fq, const u32x2 (&p)[2][2], char* g, unsigned ld) {
    LAS unsigned char* w = scr + fr * EPI_RS + 8 * fq;
#pragma unroll
    for (int bj = 0; bj < 2; ++bj)
#pragma unroll
        for (int n = 0; n < 2; ++n) *(LAS u32x2*)(w + 64 * bj + 32 * n) = p[bj][n];
    const int lane = fq * 16 + fr, rr = lane >> 3, pc = (lane & 7) * 16;
    const u32x4 q0 = *(const LAS u32x4*)(scr + rr * EPI_RS + pc), q1 = *(const LAS u32x4*)(scr + (rr + 8) * EPI_RS + pc);
    *(u32x4*)(g + rr * ld + pc) = q0; *(u32x4*)(g + (rr + 8) * ld + pc) = q1;
}
__device__ __forceinline__ void epi_rows32(LAS unsigned char* scr, int fr, int fq, const u32x2 (&p)[2], char* g, unsigned ld) {
    LAS unsigned char* w = scr + fr * 80 + 8 * fq;
    *(LAS u32x2*)(w) = p[0]; *(LAS u32x2*)(w + 32) = p[1];
    const int lane = fq * 16 + fr, rr = lane >> 2, pc = (lane & 3) * 16;
    const u32x4 q0 = *(const LAS u32x4*)(scr + rr * 80 + pc);
    *(u32x4*)(g + rr * ld + pc) = q0;
}
__device__ __forceinline__ void epi_cols16(LAS unsigned char* scr, int fr, int fq, const f32x4 (&v)[4], char* g, size_t ldc) {
    const bool odd = fr & 1;
    LAS unsigned char* w = scr + (4 * fq + (odd ? 2 : 0)) * EPI_RS + (fr >> 1) * 4;
#pragma unroll
    for (int m = 0; m < 4; ++m) {
        const float s0 = odd ? v[m].x : v[m].z, s1 = odd ? v[m].y : v[m].w;
        const float r0 = __builtin_bit_cast(float, __builtin_amdgcn_update_dpp(0, __builtin_bit_cast(int, s0), 0xB1, 0xF, 0xF, true));
        const float r1 = __builtin_bit_cast(float, __builtin_amdgcn_update_dpp(0, __builtin_bit_cast(int, s1), 0xB1, 0xF, 0xF, true));
        const unsigned w0 = odd ? pk2(r0, v[m].z) : pk2(v[m].x, r0), w1 = odd ? pk2(r1, v[m].w) : pk2(v[m].y, r1);
        *(LAS unsigned*)(w + m * 32) = w0; *(LAS unsigned*)(w + EPI_RS + m * 32) = w1;
    }
    const int lane = fq * 16 + fr, cc = lane >> 3, pc = (lane & 7) * 16;
    const u32x4 q0 = *(const LAS u32x4*)(scr + cc * EPI_RS + pc), q1 = *(const LAS u32x4*)(scr + (cc + 8) * EPI_RS + pc);
    *(u32x4*)(g + (size_t)cc * ldc + pc) = q0; *(u32x4*)(g + (size_t)(cc + 8) * ldc + pc) = q1;
}
template <class Map> struct StrideOrder {
    Map map; int NU, G, c;
    __device__ __forceinline__ bool next(int i, Unit& u) const { const long L = (long)i * G + c; if (L >= NU) return false; map((int)L, u); return true; }
};

struct MapG1 { const bf16_t* A; const bf16_t* B; int nM; int nfull;
    __device__ __forceinline__ void operator()(int L, Unit& u) const { int pm, pn;
        if (L < nfull) pg8::tile_of(L, nM, NIN / 256, pm, pn); else { const int r = L - nfull; pm = TX / 256 + (r & 7); pn = 14 + (r >> 3); }
        u.pm = pm; u.pn = pn; u.aux = 0;
        u.A = (const char*)(A + (size_t)pm * 256 * D); u.B = (const char*)(B + (size_t)pn * 256 * D); } };
struct EpiG1 { static constexpr bool IDEM = true; bf16_t *FTX, *FTC, *HTX, *HTC, *HG;
    __device__ __forceinline__ void operator()(const AccT& acc, const Unit& u, int wr, int wc, int fr, int fq, LAS unsigned char* scr) const {
        const int row0 = u.pm * 256, col0 = u.pn * 256; const bool isx = row0 < TX;
        const int b = isx ? (row0 >> 11) : ((row0 - TX) >> 8), t0 = isx ? (row0 & (LX - 1)) : 0, L = isx ? LX : LC;
        if (col0 >= 2560) {
            char* base = (char*)(HG + (size_t)(row0 + wr * 64) * HGW + (col0 - 2560) + wc * 64);
#pragma unroll
            for (int ai = 0; ai < 2; ++ai)
#pragma unroll
                for (int m = 0; m < 4; ++m) { u32x2 p[2][2];
#pragma unroll
                    for (int bj = 0; bj < 2; ++bj)
#pragma unroll
                        for (int n = 0; n < 2; ++n) { const f32x4 v = acc[ai][bj][m][n]; p[bj][n] = (u32x2){pk2(v.x, v.y), pk2(v.z, v.w)}; }
                    epi_rows64(scr, fr, fq, p, base + (size_t)(ai * 128 + m * 16) * (HGW * 2), HGW * 2); }
        } else {
            bf16_t* base; size_t ldc;
            if (col0 < 1024) { const int half = col0 >= 512; ldc = 2 * L; base = (isx ? FTX + (size_t)b * 512 * 4096 : FTC + (size_t)b * 512 * 512) + (size_t)(col0 - 512 * half) * ldc + (half ? L : 0) + t0; }
            else { ldc = L; base = (isx ? HTX + (size_t)b * 1536 * LX : HTC + (size_t)b * 1536 * LC) + (size_t)(col0 - 1024) * ldc + t0; }
            base += (size_t)(wc * 64) * ldc + wr * 64;
#pragma unroll
            for (int ai = 0; ai < 2; ++ai)
#pragma unroll
                for (int bj = 0; bj < 2; ++bj)
#pragma unroll
                    for (int n = 0; n < 2; ++n) { const f32x4 v[4] = {acc[ai][bj][0][n], acc[ai][bj][1][n], acc[ai][bj][2][n], acc[ai][bj][3][n]};
                        epi_cols16(scr, fr, fq, v, (char*)(base + (size_t)(bj * 32 + n * 16) * ldc + ai * 128), ldc * 2); }
        }
    } };

struct MapDftX { const bf16_t* A; const bf16_t* FT;
    __device__ __forceinline__ void operator()(int L, Unit& u) const { const int b = L >> 4, pm = (L >> 1) & 7, pn = L & 1; u.pm = pm; u.pn = pn; u.aux = b * LX;
        u.A = (const char*)(A + (size_t)pm * 256 * 4096); u.B = (const char*)(FT + ((size_t)b * 512 + pn * 256) * 4096); } };
struct MapDftC { const bf16_t* A; const bf16_t* FT;
    __device__ __forceinline__ void operator()(int L, Unit& u) const { const int b = L >> 1, pn = L & 1; u.pm = 0; u.pn = pn; u.aux = TX + b * LC;
        u.A = (const char*)A; u.B = (const char*)(FT + ((size_t)b * 512 + pn * 256) * 512); } };
struct OneUnit { Unit u0;
    __device__ __forceinline__ bool next(int i, Unit& u) const { if (i != 0) return false; u = u0; return true; } };
struct EpiDft { static constexpr bool IDEM = true; bf16_t* mix;
    __device__ __forceinline__ void operator()(const AccT& acc, const Unit& u, int wr, int wc, int fr, int fq, LAS unsigned char* scr) const {
        char* base = (char*)(mix + (size_t)(u.aux + u.pm * 256 + wr * 64) * D + u.pn * 256 + wc * 64);
#pragma unroll
        for (int ai = 0; ai < 2; ++ai)
#pragma unroll
            for (int m = 0; m < 4; ++m) { u32x2 p[2][2];
#pragma unroll
                for (int bj = 0; bj < 2; ++bj)
#pragma unroll
                    for (int n = 0; n < 2; ++n) { const f32x4 v = acc[ai][bj][m][n]; p[bj][n] = (u32x2){pk2(v.x, v.y), pk2(v.z, v.w)}; }
                epi_rows64(scr, fr, fq, p, base + (size_t)(ai * 128 + m * 16) * (D * 2), D * 2); }
    } };

struct MapG2 { const bf16_t* A; const bf16_t* B; int nM;
    __device__ __forceinline__ void operator()(int L, Unit& u) const { int pm, pn; pg8::tile_of(L, nM, D / 256, pm, pn); u.pm = pm; u.pn = pn; u.aux = 0;
        u.A = (const char*)(A + (size_t)pm * 256 * D); u.B = (const char*)(B + (size_t)pn * 256 * D); } };
struct EpiG2 { static constexpr bool IDEM = false; const float* xin; const float* cin; bf16_t* xcur; const float* modl; int l;
    __device__ __forceinline__ void operator()(const AccT& acc, const Unit& u, int wr, int wc, int fr, int fq, LAS unsigned char* scr) const {
        const int row0 = u.pm * 256, mr = mrow_of(row0); const int colw = u.pn * 256 + wc * 64, colb = colw + 4 * fq;
        const char* bsrc = (const char*)(row0 < TX ? xin + (size_t)row0 * D : cin + (size_t)(row0 - TX) * D);
        char* xrow = (char*)(xcur + (size_t)row0 * D);
        char* xw = xrow + ((size_t)(wr * 64) * D + colw) * 2;
        f32x4 g1[2][2];
#pragma unroll
        for (int bj = 0; bj < 2; ++bj)
#pragma unroll
            for (int n = 0; n < 2; ++n) g1[bj][n] = *(const f32x4*)(modl + (size_t)mr * MODW + 2 * D + colb + bj * 32 + n * 16);
        const int lane = fq * 16 + fr;
        if (l == 0) {
            const unsigned lo = (unsigned)((wr * 64 + (lane >> 4)) * D + colw + (lane & 15) * 4);
#pragma unroll
            for (int g2 = 0; g2 < 4; ++g2) { const int ai = g2 >> 1, m0 = (g2 & 1) * 2;
                f32x4 bs[2][4];
#pragma unroll
                for (int mm = 0; mm < 2; ++mm)
#pragma unroll
                    for (int i = 0; i < 4; ++i) bs[mm][i] = *(const f32x4*)(bsrc + (lo + (unsigned)((ai * 128 + (m0 + mm) * 16 + 4 * i) * D)) * 4u);
#pragma unroll
                for (int mm = 0; mm < 2; ++mm) {
#pragma unroll
                    for (int i = 0; i < 4; ++i) *(LAS u32x2*)(scr + ((lane >> 4) + 4 * i) * EPI_RS + (lane & 15) * 8) = (u32x2){pk2(bs[mm][i].x, bs[mm][i].y), pk2(bs[mm][i].z, bs[mm][i].w)};
                    u32x2 p[2][2];
#pragma unroll
                    for (int bj = 0; bj < 2; ++bj)
#pragma unroll
                        for (int n = 0; n < 2; ++n) { const u32x2 w = *(const LAS u32x2*)(scr + fr * EPI_RS + 64 * bj + 32 * n + 8 * fq);
                            const f32x4 v = (f32x4){bflo(w.x), bfhi(w.x), bflo(w.y), bfhi(w.y)} + g1[bj][n] * acc[ai][bj][m0 + mm][n]; p[bj][n] = (u32x2){pk2(v.x, v.y), pk2(v.z, v.w)}; }
                    epi_rows64(scr, fr, fq, p, xw + (size_t)(ai * 128 + (m0 + mm) * 16) * (D * 2), D * 2); }
            }
        } else {
            const unsigned lo = (unsigned)((lane >> 3) * D * 2 + (lane & 7) * 16);
#pragma unroll
            for (int ai = 0; ai < 2; ++ai) {
                u32x4 bw[4][2];
#pragma unroll
                for (int m = 0; m < 4; ++m)
#pragma unroll
                    for (int i = 0; i < 2; ++i) bw[m][i] = *(const u32x4*)(xw + (size_t)(ai * 128 + m * 16 + 8 * i) * (D * 2) + lo);
#pragma unroll
                for (int m = 0; m < 4; ++m) {
#pragma unroll
                    for (int i = 0; i < 2; ++i) *(LAS u32x4*)(scr + ((lane >> 3) + 8 * i) * EPI_RS + (lane & 7) * 16) = bw[m][i];
                    u32x2 p[2][2];
#pragma unroll
                    for (int bj = 0; bj < 2; ++bj)
#pragma unroll
                        for (int n = 0; n < 2; ++n) { const u32x2 w = *(const LAS u32x2*)(scr + fr * EPI_RS + 64 * bj + 32 * n + 8 * fq);
                            const f32x4 v = (f32x4){bflo(w.x), bfhi(w.x), bflo(w.y), bfhi(w.y)} + g1[bj][n] * acc[ai][bj][m][n]; p[bj][n] = (u32x2){pk2(v.x, v.y), pk2(v.z, v.w)}; }
                    epi_rows64(scr, fr, fq, p, xw + (size_t)(ai * 128 + m * 16) * (D * 2), D * 2); }
            }
        }
    } };

struct MapE1 { const bf16_t* XS; const bf16_t* W; int ntm;
    __device__ __forceinline__ void operator()(int L, Unit& u) const { const int per = ntm * 8, e = L / per, r = L % per; u.pm = r % ntm; u.pn = r / ntm; u.aux = e;
        u.A = (const char*)XS; u.B = (const char*)(W + ((size_t)e * 2 * FF + u.pn * 256) * D); } };
struct EpiE1 { static constexpr bool IDEM = true; bf16_t* hid;
    __device__ __forceinline__ void operator()(const AccT& acc, const Unit& u, int wr, int wc, int fr, int fq, LAS unsigned char* scr) const {
        char* base = (char*)(hid + ((size_t)u.aux * ROWS_E + u.pm * 256 + wr * 64) * FF + u.pn * 128 + wc * 32);
#pragma unroll
        for (int ai = 0; ai < 2; ++ai)
#pragma unroll
            for (int m = 0; m < 4; ++m) { u32x2 p[2];
#pragma unroll
                for (int n = 0; n < 2; ++n) { const f32x4 g = acc[ai][0][m][n], v = acc[ai][1][m][n];
                    const float h0 = g.x * sigmoidf_(g.x) * v.x, h1 = g.y * sigmoidf_(g.y) * v.y, h2 = g.z * sigmoidf_(g.z) * v.z, h3 = g.w * sigmoidf_(g.w) * v.w;
                    p[n] = (u32x2){pk2(h0, h1), pk2(h2, h3)}; }
                epi_rows32(scr, fr, fq, p, base + (size_t)(ai * 128 + m * 16) * (FF * 2), FF * 2); }
    } };

struct MapE2 { const bf16_t* H; const bf16_t* W; int ntm;
    __device__ __forceinline__ void operator()(int L, Unit& u) const { const int per = ntm * 8, e = L / per, r = L % per; u.pm = r % ntm; u.pn = r / ntm; u.aux = e;
        u.A = (const char*)(H + ((size_t)e * ROWS_E + u.pm * 256) * FF); u.B = (const char*)(W + ((size_t)e * D + u.pn * 256) * FF); } };
struct EpiE2 { static constexpr bool IDEM = true; bf16_t* Y; const float* gate;
    __device__ __forceinline__ void operator()(const AccT& acc, const Unit& u, int wr, int wc, int fr, int fq, LAS unsigned char* scr) const {
        const size_t rw = (size_t)u.aux * ROWS_E + u.pm * 256 + wr * 64, rb = rw + fr;
        char* base = (char*)(Y + rw * D + u.pn * 256 + wc * 64);
        float gts[2][4];
#pragma unroll
        for (int ai = 0; ai < 2; ++ai)
#pragma unroll
            for (int m = 0; m < 4; ++m) gts[ai][m] = gate[rb + ai * 128 + m * 16];
#pragma unroll
        for (int ai = 0; ai < 2; ++ai)
#pragma unroll
            for (int m = 0; m < 4; ++m) { const float gt = gts[ai][m]; u32x2 p[2][2];
#pragma unroll
                for (int bj = 0; bj < 2; ++bj)
#pragma unroll
                    for (int n = 0; n < 2; ++n) { const f32x4 v = acc[ai][bj][m][n] * gt; p[bj][n] = (u32x2){pk2(v.x, v.y), pk2(v.z, v.w)}; }
                epi_rows64(scr, fr, fq, p, base + (size_t)(ai * 128 + m * 16) * (D * 2), D * 2); }
    } };

constexpr int HQ_QP = 0, HQ_KV = 17408, HQ_KHT = 60928, HQ_VT = 79360, HQ_AM = 97792, HQ_ST = 107008, HQ_TOT = 141824, HQ_DV = 145920, HQ_END = 146432;
constexpr int RS_K = 272, RS_S = 144;
static_assert(HQ_END <= LDS_CTL, "hgrn LDS map");
#ifndef HG_REP
#define HG_REP 0
#endif
#define MFMA16(a_, b_, c_) __builtin_amdgcn_mfma_f32_16x16x32_bf16((a_), (b_), (c_), 0, 0, 0)
__device__ __forceinline__ void hgrn_seq(const Args& a, LAS unsigned char* lds, int l, int unit) {
    const int tid = opaque(TIDX(a)), lane = tid & 63, wave = __builtin_amdgcn_readfirstlane(tid >> 6);
    const int b = unit >> 4, h = (unit >> 1) & 7, dir = unit & 1;
    const int J = wave >> 1, hf = wave & 1;
    const int lr = lane & 15, lq = lane >> 4;
    const bf16_t* HG = WSP(bf16_t, WS_HG);
    bf16_t* OUT = dir ? WSP(bf16_t, WS_OB) : WSP(bf16_t, WS_OF);
    float lb[2] = {0.f, 0.f};
    if (l == 1) {
#pragma unroll
        for (int c = 0; c < 2; ++c) { const int ch = h * 128 + 2 * lane + c; const float a0 = a.in[I_HGLB][(0 * 2 + dir) * 1024 + ch], a1 = a.in[I_HGLB][(1 * 2 + dir) * 1024 + ch]; lb[c] = 1.0f / (1.0f + __expf(a0 - a1)); } }
    for (int i = tid; i < (HQ_TOT - HQ_AM) / 16; i += 512) *(LAS u32x4*)(lds + HQ_AM + i * 16) = (u32x4){0u, 0u, 0u, 0u};
    f32x4 S[2][4];
#pragma unroll
    for (int i = 0; i < 2; ++i)
#pragma unroll
        for (int j = 0; j < 4; ++j) S[i][j] = (f32x4){0.f, 0.f, 0.f, 0.f};
    const int kt0 = 2 * (wave >> 1), vt0 = 4 * (wave & 1);
    __syncthreads();
    const int colq = h * 128 + 2 * lane, colf = (1 + dir) * 1024 + colq, colv = 3 * 1024 + colq;
    unsigned pzq[8], pzf[8], pzv[8];
    {
#pragma unroll
        for (int m = 0; m < 8; ++m) { const int i = 8 * wave + m; const int t = dir ? (LC - 1 - i) : i; const bf16_t* p = HG + (size_t)(TX + b * LC + t) * HGW;
            pzq[m] = *(const unsigned*)(p + colq); pzf[m] = *(const unsigned*)(p + colf); pzv[m] = *(const unsigned*)(p + colv); }
    }
    u32x2 opk[4]; int oci = -1;
#pragma unroll
    for (int it = 0; it < 4; ++it) opk[it] = (u32x2){0u, 0u};
    auto flush_o = [&]() {
        if (oci >= 0) { const bool ox = oci >= 4; const int oL = ox ? LX : LC, orb = ox ? b * LX : TX + b * LC, ojc = ox ? oci - 4 : oci;
#pragma unroll
            for (int it = 0; it < 4; ++it) { const int i = 64 * ojc + 16 * it + lr; const int t = dir ? (oL - 1 - i) : i;
                *(u32x2*)(OUT + (size_t)(orb + t) * 1024 + h * 128 + 16 * wave + 4 * lq) = opk[it]; }
            oci = -1; } };
    for (int ci = 0; ci < 36; ++ci) {
        const bool isx = ci >= 4; const int L = isx ? LX : LC, rowbase = isx ? b * LX : TX + b * LC, jc = isx ? ci - 4 : ci;
        f32x2 q[8], P[8], e1[8], fv[8]; unsigned vv[8];
        {
            const f32x2 lb2 = {lb[0], lb[1]}, omlb = (f32x2){1.0f, 1.0f} - lb2;
            f32x2 run = {1.f, 1.f};
#pragma unroll
            for (int m = 0; m < 8; ++m) { const f32x2 zq = {bflo(pzq[m]), bfhi(pzq[m])}, zf = {bflo(pzf[m]), bfhi(pzf[m])};
                q[m] = zq * (f32x2){sigmoidf_(zq.x), sigmoidf_(zq.y)};
                const f32x2 f = __builtin_elementwise_max(lb2 + omlb * (f32x2){sigmoidf_(zf.x), sigmoidf_(zf.y)}, (f32x2){1e-6f, 1e-6f});
                fv[m] = f; run *= f; P[m] = run; }
            f32x2 suf = {1.f, 1.f};
#pragma unroll
            for (int m = 7; m >= 0; --m) { e1[m] = suf; suf *= fv[m]; }
            ((LAS float*)(lds + HQ_TOT))[(2 * lane) * 8 + wave] = P[7].x; ((LAS float*)(lds + HQ_TOT))[(2 * lane + 1) * 8 + wave] = P[7].y;
        }
#pragma unroll
        for (int m = 0; m < 8; ++m) vv[m] = pzv[m];
        __syncthreads();
        flush_o();
        f32x2 EJ, GS, pre, post, tt[4];
        {
            const f32x4 sa0 = *(const LAS f32x4*)(lds + HQ_TOT + (2 * lane) * 32), sb0 = *(const LAS f32x4*)(lds + HQ_TOT + (2 * lane) * 32 + 16);
            const f32x4 sa1 = *(const LAS f32x4*)(lds + HQ_TOT + (2 * lane + 1) * 32), sb1 = *(const LAS f32x4*)(lds + HQ_TOT + (2 * lane + 1) * 32 + 16);
            const f32x2 sg[8] = {{sa0.x, sa1.x}, {sa0.y, sa1.y}, {sa0.z, sa1.z}, {sa0.w, sa1.w}, {sb0.x, sb1.x}, {sb0.y, sb1.y}, {sb0.z, sb1.z}, {sb0.w, sb1.w}};
#pragma unroll
            for (int jj = 0; jj < 4; ++jj) tt[jj] = sg[2 * jj] * sg[2 * jj + 1];
            EJ = (f32x2){1.f, 1.f}; GS = EJ;
#pragma unroll
            for (int jj = 0; jj < 4; ++jj) { if (jj < J) EJ *= tt[jj]; if (jj > J) GS *= tt[jj]; }
            f32x2 first = sg[0], second = sg[1];
#pragma unroll
            for (int jj = 1; jj < 4; ++jj) { if (jj == J) { first = sg[2 * jj]; second = sg[2 * jj + 1]; } }
            pre = hf ? first : (f32x2){1.f, 1.f}; post = hf ? (f32x2){1.f, 1.f} : second;
        }
        {
#pragma unroll
            for (int m = 0; m < 8; ++m) {
                const f32x2 Pf = P[m] * pre; P[m] = Pf;
                const f32x2 Qv = q[m] * Pf, kkm = (f32x2){1.0f, 1.0f} - fv[m], ke = kkm * (e1[m] * post);
                const f32x2 Kd = kkm * __builtin_elementwise_min((f32x2){__builtin_amdgcn_rcpf(Pf.x), __builtin_amdgcn_rcpf(Pf.y)}, (f32x2){1e30f, 1e30f});
                const int row = 8 * wave + m, rs = 8 * hf + m;
                *(LAS unsigned*)(lds + HQ_QP + row * RS_K + 4 * lane) = pk2(Qv.x, Qv.y);
                *(LAS unsigned*)(lds + HQ_KV + (16 * (J * (J + 1) / 2 + J) + rs) * RS_K + 4 * lane) = pk2(Kd.x, Kd.y);
                f32x2 Gm = {1.f, 1.f};
#pragma unroll
                for (int I = 1; I < 4; ++I) { if (I > J) { const f32x2 kv = ke * Gm; *(LAS unsigned*)(lds + HQ_KV + (16 * (I * (I + 1) / 2 + J) + rs) * RS_K + 4 * lane) = pk2(kv.x, kv.y); Gm *= tt[I]; } }
                e1[m] = ke * GS;
            }
            *(LAS u32x4*)(lds + HQ_KHT + (2 * lane) * RS_S + 16 * wave) = (u32x4){pk2(e1[0].x, e1[1].x), pk2(e1[2].x, e1[3].x), pk2(e1[4].x, e1[5].x), pk2(e1[6].x, e1[7].x)};
            *(LAS u32x4*)(lds + HQ_KHT + (2 * lane + 1) * RS_S + 16 * wave) = (u32x4){pk2(e1[0].y, e1[1].y), pk2(e1[2].y, e1[3].y), pk2(e1[4].y, e1[5].y), pk2(e1[6].y, e1[7].y)};
            *(LAS u32x4*)(lds + HQ_VT + (2 * lane) * RS_S + 16 * wave) = (u32x4){(vv[0] & 0xffffu) | (vv[1] << 16), (vv[2] & 0xffffu) | (vv[3] << 16), (vv[4] & 0xffffu) | (vv[5] << 16), (vv[6] & 0xffffu) | (vv[7] << 16)};
            *(LAS u32x4*)(lds + HQ_VT + (2 * lane + 1) * RS_S + 16 * wave) = (u32x4){(vv[0] >> 16) | (vv[1] & 0xffff0000u), (vv[2] >> 16) | (vv[3] & 0xffff0000u), (vv[4] >> 16) | (vv[5] & 0xffff0000u), (vv[6] >> 16) | (vv[7] & 0xffff0000u)};
            if (wave == 0) *(LAS f32x2*)(lds + HQ_DV + 8 * lane) = (tt[0] * tt[1]) * (tt[2] * tt[3]);
        }
        __syncthreads();
        if (ci + 1 < 36) {
            const bool nx = (ci + 1) >= 4; const int Ln = nx ? LX : LC, rbn = nx ? b * LX : TX + b * LC, jn = nx ? ci + 1 - 4 : ci + 1;
#pragma unroll
            for (int m = 0; m < 8; ++m) { const int i = 64 * jn + 8 * wave + m; const int t = dir ? (Ln - 1 - i) : i; const bf16_t* p = HG + (size_t)(rbn + t) * HGW;
                pzq[m] = *(const unsigned*)(p + colq); pzf[m] = *(const unsigned*)(p + colf); pzv[m] = *(const unsigned*)(p + colv); }
        }
        const bool need_o = isx || l == 0;
        _Pragma("unroll") for (int rr_ = 0; rr_ < 1 + ((HG_REP >> 2) & 1); ++rr_)
        if (need_o) for (int vb = wave; vb < 10; vb += 8) {
            const int I = (vb >= 6) ? 3 : (vb >= 3) ? 2 : (vb >= 1) ? 1 : 0, Jp = vb - I * (I + 1) / 2;
            f32x4 c = (f32x4){0.f, 0.f, 0.f, 0.f};
#pragma unroll
            for (int ks = 0; ks < 4; ++ks) {
                const bf16x8 af = *(const LAS bf16x8*)(lds + HQ_KV + (16 * vb + lr) * RS_K + ks * 64 + lq * 16);
                const bf16x8 bf = *(const LAS bf16x8*)(lds + HQ_QP + (16 * I + lr) * RS_K + ks * 64 + lq * 16);
                c = MFMA16(af, bf, c);
            }
            if (I == Jp) { c.x = (4 * lq + 0 <= lr) ? c.x : 0.f; c.y = (4 * lq + 1 <= lr) ? c.y : 0.f; c.z = (4 * lq + 2 <= lr) ? c.z : 0.f; c.w = (4 * lq + 3 <= lr) ? c.w : 0.f; }
            *(LAS u32x2*)(lds + HQ_AM + (16 * I + lr) * RS_S + (16 * Jp + 4 * lq) * 2) = (u32x2){pk2(c.x, c.y), pk2(c.z, c.w)};
        }
        __syncthreads();
        {
#pragma unroll
            for (int m = 0; m < 8; ++m) { const f32x2 qt = q[m] * P[m] * EJ; *(LAS unsigned*)(lds + HQ_QP + (8 * wave + m) * RS_K + 4 * lane) = pk2(qt.x, qt.y); }
        }
        __syncthreads();
        _Pragma("unroll") for (int rr_ = 0; rr_ < 1 + ((HG_REP >> 3) & 1); ++rr_)
        if (need_o) {
            f32x4 o[4];
#pragma unroll
            for (int it = 0; it < 4; ++it) o[it] = (f32x4){0.f, 0.f, 0.f, 0.f};
#pragma unroll
            for (int ks = 0; ks < 4; ++ks) { const bf16x8 af = *(const LAS bf16x8*)(lds + HQ_ST + (16 * wave + lr) * RS_K + ks * 64 + lq * 16);
#pragma unroll
                for (int it = 0; it < 4; ++it) { const bf16x8 bf = *(const LAS bf16x8*)(lds + HQ_QP + (16 * it + lr) * RS_K + ks * 64 + lq * 16); o[it] = MFMA16(af, bf, o[it]); } }
#pragma unroll
            for (int ks = 0; ks < 2; ++ks) { const bf16x8 af = *(const LAS bf16x8*)(lds + HQ_VT + (16 * wave + lr) * RS_S + ks * 64 + lq * 16);
#pragma unroll
                for (int it = 0; it < 4; ++it) { if (ks == 1 && it < 2) continue; const bf16x8 bf = *(const LAS bf16x8*)(lds + HQ_AM + (16 * it + lr) * RS_S + ks * 64 + lq * 16); o[it] = MFMA16(af, bf, o[it]); } }
#pragma unroll
            for (int it = 0; it < 4; ++it) opk[it] = (u32x2){pk2(o[it].x, o[it].y), pk2(o[it].z, o[it].w)};
            oci = ci;
        }
        {
#pragma unroll
            for (int kti = 0; kti < 2; ++kti) { const f32x4 dv = *(const LAS f32x4*)(lds + HQ_DV + (16 * (kt0 + kti) + 4 * lq) * 4);
#pragma unroll
                for (int vti = 0; vti < 4; ++vti) S[kti][vti] *= dv; }
#pragma unroll
            for (int ks = 0; ks < 2; ++ks) { bf16x8 af[2];
#pragma unroll
                for (int kti = 0; kti < 2; ++kti) af[kti] = *(const LAS bf16x8*)(lds + HQ_KHT + (16 * (kt0 + kti) + lr) * RS_S + ks * 64 + lq * 16);
#pragma unroll
                for (int vti = 0; vti < 4; ++vti) { const bf16x8 bf = *(const LAS bf16x8*)(lds + HQ_VT + (16 * (vt0 + vti) + lr) * RS_S + ks * 64 + lq * 16);
#pragma unroll
                    for (int kti = 0; kti < 2; ++kti) S[kti][vti] = MFMA16(af[kti], bf, S[kti][vti]); } }
        }
        __syncthreads();
#pragma unroll
        for (int kti = 0; kti < 2; ++kti)
#pragma unroll
            for (int vti = 0; vti < 4; ++vti) { const f32x4 s = S[kti][vti];
                *(LAS u32x2*)(lds + HQ_ST + (16 * (vt0 + vti) + lr) * RS_K + (16 * (kt0 + kti) + 4 * lq) * 2) = (u32x2){pk2(s.x, s.y), pk2(s.z, s.w)}; }
    }
    flush_o();
    __syncthreads();
}

constexpr int HY_CSTR = 8224;
__device__ __forceinline__ void hyena_unit(const Args& a, LAS unsigned char* lds, int l, bool isx, int c) {
    const int tid = opaque(TIDX(a)), lane = tid & 63, wave = __builtin_amdgcn_readfirstlane(tid >> 6);
    const int L = isx ? LX : LC, NA = L / 64;
    const int ZSTR = (NA + 6) * 128 + 16, XSTR = L * 2 + 16;
    const int OFF_Z = 0, OFF_X0 = 8 * ZSTR, OFF_KC = OFF_X0 + 8 * XSTR;
    const bf16_t* HT = isx ? WSP(bf16_t, WS_HTX) : WSP(bf16_t, WS_HTC);
    const bf16_t* kr = (isx ? WSP(bf16_t, WS_KRX) + (size_t)l * 512 * KRX_LD + (size_t)c * KRX_LD : WSP(bf16_t, WS_KRC) + (size_t)l * 512 * KRC_LD + (size_t)c * KRC_LD);
    __syncthreads();
    for (int i = tid; i < 8 * 2 * 24; i += 512) { const int b = i / 48, r = i % 48; const int off = (r < 24) ? r * 16 : (192 + L) * 2 + (r - 24) * 16; *(LAS u32x4*)(lds + OFF_Z + b * ZSTR + off) = (u32x4){0u, 0u, 0u, 0u}; }
    {
        float w[3][3], bias[3];
#pragma unroll
        for (int s = 0; s < 3; ++s) { bias[s] = a.in[I_HCB][l * 1536 + s * 512 + c];
#pragma unroll
            for (int j = 0; j < 3; ++j) w[s][j] = a.in[I_HCW][(l * 3 + j) * 1536 + s * 512 + c]; }
        for (int g = tid; g < L; g += 512) { const int b = g / (L / 8), t0 = (g % (L / 8)) * 8;
            float uc[3][8];
#pragma unroll
            for (int s = 0; s < 3; ++s) { const bf16_t* p = HT + ((size_t)b * 1536 + s * 512 + c) * L;
                const u32x4 v = *(const u32x4*)(p + t0); float u[10];
                u[0] = (t0 > 0) ? bf2f(p[t0 - 1]) : 0.f; u[9] = (t0 + 8 < L) ? bf2f(p[t0 + 8]) : 0.f;
                u[1] = bflo(v.x); u[2] = bfhi(v.x); u[3] = bflo(v.y); u[4] = bfhi(v.y); u[5] = bflo(v.z); u[6] = bfhi(v.z); u[7] = bflo(v.w); u[8] = bfhi(v.w);
#pragma unroll
                for (int i = 0; i < 8; ++i) uc[s][i] = w[s][0] * u[i] + w[s][1] * u[i + 1] + w[s][2] * u[i + 2] + bias[s]; }
            float z[8];
#pragma unroll
            for (int i = 0; i < 8; ++i) z[i] = uc[1][i] * uc[0][i];
            *(LAS u32x4*)(lds + OFF_Z + b * ZSTR + (192 + t0) * 2) = (u32x4){pk2(z[0], z[1]), pk2(z[2], z[3]), pk2(z[4], z[5]), pk2(z[6], z[7])};
            *(LAS u32x4*)(lds + OFF_X0 + b * XSTR + t0 * 2) = (u32x4){pk2(uc[2][0], uc[2][1]), pk2(uc[2][2], uc[2][3]), pk2(uc[2][4], uc[2][5]), pk2(uc[2][6], uc[2][7])};
        }
    }
    for (int g = tid; g < 2 * L / 8; g += 512) {
        const u32x4 qa = *(const u32x4*)(kr + 8 * g), qb = *(const u32x4*)(kr + 8 * g + 8);
        const unsigned cw[8] = {qa.x, qa.y, qa.z, qa.w, qb.x, qb.y, qb.z, qb.w};
#pragma unroll
        for (int s = 0; s < 8; ++s) { const int d = s >> 1; u32x4 o;
            if (s & 1) o = (u32x4){__builtin_amdgcn_alignbit(cw[d + 1], cw[d], 16), __builtin_amdgcn_alignbit(cw[d + 2], cw[d + 1], 16), __builtin_amdgcn_alignbit(cw[d + 3], cw[d + 2], 16), __builtin_amdgcn_alignbit(cw[d + 4], cw[d + 3], 16)};
            else o = (u32x4){cw[d], cw[d + 1], cw[d + 2], cw[d + 3]};
            *(LAS u32x4*)(lds + OFF_KC + s * HY_CSTR + g * 16) = o; } }
    __syncthreads();
    const int lr = lane & 15, lq = lane >> 4;
    if (4 * wave < NA) {
        f32x4 acc[4][2];
#pragma unroll
        for (int mt = 0; mt < 4; ++mt) { acc[mt][0] = (f32x4){0.f, 0.f, 0.f, 0.f}; acc[mt][1] = acc[mt][0]; }
        const int bb = lr & 7, ao = lr >> 3;
        const int dlo = 4 * wave - NA + 1, dhi = 4 * wave + 3;
        for (int d = dlo; d <= dhi; ++d) {
#pragma unroll
            for (int ks = 0; ks < 2; ++ks) {
                bf16x8 bfr[2];
#pragma unroll
                for (int nt = 0; nt < 2; ++nt) { const int ap = 2 * (2 * wave + nt) + ao; bfr[nt] = *(const LAS bf16x8*)(lds + OFF_Z + bb * ZSTR + ((ap - d + 3) * 64 + 32 * ks + 8 * lq) * 2); }
#pragma unroll
                for (int mt = 0; mt < 4; ++mt) { const int rp = 16 * mt + lr; const int i0 = 32 * ks + 8 * lq - rp - 64 * d + L; const int s = i0 & 7;
                    const bf16x8 afr = *(const LAS bf16x8*)(lds + OFF_KC + s * HY_CSTR + (i0 - s) * 2);
                    acc[mt][0] = MFMA16(afr, bfr[0], acc[mt][0]); acc[mt][1] = MFMA16(afr, bfr[1], acc[mt][1]); }
            }
        }
        const float dbias = a.in[I_HBIAS][l * 512 + c];
        bf16_t* hy = (isx ? WSP(bf16_t, WS_HTX) : WSP(bf16_t, WS_HTC)) + ((size_t)bb * 1536 + c) * L;
#pragma unroll
        for (int mt = 0; mt < 4; ++mt)
#pragma unroll
            for (int nt = 0; nt < 2; ++nt) { const int ap = 2 * (2 * wave + nt) + ao; const f32x4 y = acc[mt][nt]; const int t = 64 * ap + 16 * mt + 4 * lq;
                const u32x2 zw = *(const LAS u32x2*)(lds + OFF_Z + bb * ZSTR + (192 + t) * 2), xw = *(const LAS u32x2*)(lds + OFF_X0 + bb * XSTR + t * 2);
                const float o0 = bflo(xw.x) * (y.x + dbias * bflo(zw.x)), o1 = bfhi(xw.x) * (y.y + dbias * bfhi(zw.x)), o2 = bflo(xw.y) * (y.z + dbias * bflo(zw.y)), o3 = bfhi(xw.y) * (y.w + dbias * bfhi(zw.y));
                *(u32x2*)(hy + t) = (u32x2){pk2(o0, o1), pk2(o2, o3)}; }
    }
}

constexpr int NPH_LAYER = 10, NPH = 2 + 2 * NPH_LAYER;
__global__ void __launch_bounds__(512, 2) mk_fwd(Args a_in) {
    Args a = a_in; a.wv = __builtin_amdgcn_readfirstlane((int)threadIdx.x >> 6);
    extern __shared__ __attribute__((aligned(16))) unsigned char lds_raw[];
    LAS unsigned char* lds = (LAS unsigned char*)lds_raw;
    const int bid = blockIdx.x, G = gridDim.x;
    volatile LAS unsigned* LCTL = (volatile LAS unsigned*)(lds + LDS_CTL);
    if (a.wv == 0) LCTL[lane_id_()] = 0u;
    __syncthreads();
    unsigned* ctl = WSP(unsigned, WS_CTL);
    XcdBarrier bar; bar.bar = ctl + CW_BAR; bar.x = 0; bar.st = nullptr;
    bar.wv = a.wv;
    if (!MK_MULTI) bar = xcd_barrier_post(ctl + CW_BAR, LCTL, a.wv);
    const int lo = a.ph_lo, hi = a.ph_hi;
#ifndef PHASE_MASK
#define PHASE_MASK 0xFFFFF
#endif
#define ON(b) ((PHASE_MASK >> (b)) & 1)
#ifndef REPEAT_MASK
#define REPEAT_MASK 0
#endif
#define REP(b) _Pragma("unroll") for (int rep_ = 0; rep_ < 1 + ((REPEAT_MASK >> (b)) & 1); ++rep_)
#define REP2(b) _Pragma("unroll") for (int rep2_ = 0; rep2_ < 1 + ((REPEAT_MASK >> (b)) & 1); ++rep2_)
#define IN(k) (lo <= (k) && (k) < hi)
#define SEAM(k) do { if (IN(k) && IN((k) + 1)) xcd_barrier(bar); } while (0)

    if (ON(0) && IN(0)) REP(0) { p0_prologue(a, lds, bid, G); }
    SEAM(0);
    for (int l = 0; l < 2; ++l) {
        const int pb = 1 + NPH_LAYER * l;
        const bf16_t* WinT = WSP(bf16_t, WS_WIN + l * WIN_BYTES); const bf16_t* WoutT = WSP(bf16_t, WS_WOUT + l * WOUT_BYTES);
        const bf16_t* WguT = WSP(bf16_t, WS_WGU + l * WGU_BYTES); const bf16_t* WdT = WSP(bf16_t, WS_WD + l * WD_BYTES);
        if (ON(1) && IN(pb + 0)) REP(1) { if (l == 0) norm_pass<0>(a, bid, G); else norm_pass<1>(a, bid, G); }
        SEAM(pb + 0);
        if (ON(2) && IN(pb + 1)) REP(2) {
            const int nMg = (l == 0) ? TT / 256 : TX / 256, nfull = nMg * (NIN / 256);
            StrideOrder<MapG1> S{MapG1{WSP(bf16_t, WS_XM), WinT, nMg, nfull}, nfull + (l == 0 ? 0 : (TC / 256) * 12), G, bid};
            EpiG1 E{WSP(bf16_t, WS_FTX), WSP(bf16_t, WS_FTC), WSP(bf16_t, WS_HTX), WSP(bf16_t, WS_HTC), WSP(bf16_t, WS_HG)};
            pg8::gemm_phase<EpiG1, StrideOrder<MapG1>>(lds, D, D, D, S, E, a.wv);
            if (l == 0 && G == 256 && bid >= 112) { __syncthreads(); tail_copy(a, lds, TS_G1, TAILC_G1, bid - 112, 144); }
            if (l == 1 && G == 256 && bid >= 224) { __syncthreads(); tail_copy(a, lds, TS_G1L1, TAILC_G1L1, bid - 224, 32); }
        }
        SEAM(pb + 1);
        if (ON(3) && IN(pb + 2)) REP(3) {
            if (ON(12)) REP2(12) { for (int u = bid; u < 128; u += G) hgrn_seq(a, lds, l, u); }
            if (ON(13)) REP2(13) { StrideOrder<MapDftX> S1{MapDftX{WSP(bf16_t, WS_DFTX), WSP(bf16_t, WS_FTX)}, 128, G, (bid + G - (128 % G)) % G}; EpiDft E{WSP(bf16_t, WS_MIX)};
                pg8::gemm_phase<EpiDft, StrideOrder<MapDftX>>(lds, 2 * LX, 2 * LX, 2 * LX, S1, E, a.wv); }
            if (ON(14) && l == 0) { StrideOrder<MapDftC> S1{MapDftC{WSP(bf16_t, WS_DFTC), WSP(bf16_t, WS_FTC)}, 16, G, (bid + G - (240 % G)) % G}; EpiDft E{WSP(bf16_t, WS_MIX)};
                pg8::gemm_phase<EpiDft, StrideOrder<MapDftC>>(lds, 2 * LC, 2 * LC, 2 * LC, S1, E, a.wv); }
            if (ON(15)) REP2(15) {
                const int nq = (l == 0) ? 1024 : 512;
                for (;;) {
                    __syncthreads();
                    if (TIDX(a) == 0) LCTL[4] = xb_add(ctl + CW_QUEUE + 64 * (l + 2 * rep_ + 4 * rep2_), 1u);
                    __syncthreads();
                    const int it = (int)LCTL[4];
                    if (it >= nq) break;
                    hyena_unit(a, lds, l, it < 512, it & 511);
                }
            }
            if (G == 256 && bid >= 128) { __syncthreads(); tail_copy(a, lds, l == 0 ? TS_M0 : TS_M1, l == 0 ? TAILC_M0 : TAILC_M1, bid - 128, 128); }
            __syncthreads();
        }
        SEAM(pb + 2);
        if (ON(4) && IN(pb + 3)) REP(4) hgrn_out_pass(a, lds, l, bid, G);
        SEAM(pb + 3);
        if (ON(5) && IN(pb + 4)) REP(5) {
            const int nM = (l == 0) ? TT / 256 : TX / 256;
            StrideOrder<MapG2> S{MapG2{WSP(bf16_t, WS_MIX), WoutT, nM}, nM * (D / 256), G, bid};
            EpiG2 E{a.in[I_X], a.in[I_CTX], WSP(bf16_t, WS_XCUR), WSP(float, WS_MOD) + (size_t)l * 9 * MODW, l};
            pg8::gemm_phase<EpiG2, StrideOrder<MapG2>>(lds, D, D, D, S, E, a.wv);
            if (l == 0 && G == 256 && bid >= 64) { __syncthreads(); tail_copy(a, lds, TS_G2, TAILC_G2, bid - 64, 192); }
        }
        SEAM(pb + 4);
        if (ON(6) && IN(pb + 5)) REP(6) n2_pass(a, lds, l, bid, G);
        SEAM(pb + 5);
        if (ON(7) && IN(pb + 6)) REP(7) topk_pass(a, lds, l, bid, G);
        SEAM(pb + 6);
        if (ON(9) && IN(pb + 8)) REP(9) {
            const int ntm = (l == 0) ? ROWS_E / 256 : (NB * CAPX) / 256;
            const int vcu = (G % 8 == 0) ? (bid % 8) * (G / 8) + bid / 8 : bid;
            StrideOrder<MapE1> S{MapE1{WSP(bf16_t, WS_XM), WguT, ntm}, NE * ntm * 8, G, vcu};
            EpiE1 E{WSP(bf16_t, WS_HID)};
            LAS int* gidx = (LAS int*)(lds + pg8::STAGE_BYTES);
            { const int tid_ = opaque(TIDX(a)); Unit uu;
              for (int i = 0; i < pg8::GIDX_UNITS && S.next(i, uu); ++i) { if (tid_ < 256) gidx[i * 256 + tid_] = WSP(int, WS_IDX)[uu.aux * ROWS_E + uu.pm * 256 + tid_]; }
              __syncthreads(); }
            pg8::gemm_phase<EpiE1, StrideOrder<MapE1>, true, true, true, false>(lds, D, D, D, S, E, a.wv, gidx);
            if (l == 0 && G == 256 && vcu >= 128) { __syncthreads(); tail_copy(a, lds, TS_E1, TAILC_E1, vcu - 128, 128); }
        }
        SEAM(pb + 8);
        if (ON(10) && IN(pb + 9)) REP(10) {
            const int ntm = (l == 0) ? ROWS_E / 256 : (NB * CAPX) / 256;
            const int vcu = (G % 8 == 0) ? (bid % 8) * (G / 8) + bid / 8 : bid;
            StrideOrder<MapE2> S{MapE2{WSP(bf16_t, WS_HID), WdT, ntm}, NE * ntm * 8, G, vcu};
            EpiE2 E{WSP(bf16_t, WS_Y), WSP(float, WS_GATE)};
            pg8::gemm_phase<EpiE2, StrideOrder<MapE2>>(lds, FF, FF, FF, S, E, a.wv);
            if (l == 0 && G == 256 && vcu >= 128) { __syncthreads(); tail_copy(a, lds, TS_E2, TAILC_E2, vcu - 128, 128); }
        }
        SEAM(pb + 9);
    }
    if (ON(11) && IN(NPH - 1)) REP(11) norm_pass<2>(a, bid, G);
#undef IN
#undef SEAM
}

extern "C" void kernel_launch(void* const* d_in, const int* in_sizes, int n_in, void* d_out, int out_size, void* d_ws, size_t ws_size, hipStream_t stream) {
    static int grid = 0;
    if (grid == 0) {
        if (n_in != 29 || in_sizes[0] != TX * D || out_size != TX * D || ws_size < WS_END) {
            fprintf(stderr, "kernel_launch: unexpected shapes (n_in %d, in0 %d, out %d, ws %zu, need %zu); nothing launched\n", n_in, n_in > 0 ? in_sizes[0] : -1, out_size, ws_size, (size_t)WS_END); grid = -1; return; }
        int dev = 0, cus = 0, per_cu = 0;
        if (hipGetDevice(&dev) != hipSuccess || hipDeviceGetAttribute(&cus, hipDeviceAttributeMultiprocessorCount, dev) != hipSuccess) { grid = -1; return; }
        if (hipFuncSetAttribute((const void*)mk_fwd, hipFuncAttributeMaxDynamicSharedMemorySize, LDS_BYTES) != hipSuccess) { fprintf(stderr, "kernel_launch: hipFuncSetAttribute failed\n"); grid = -1; return; }
        if (hipOccupancyMaxActiveBlocksPerMultiprocessor(&per_cu, (const void*)mk_fwd, 512, LDS_BYTES) != hipSuccess || per_cu < 1)
            fprintf(stderr, "kernel_launch: note: occupancy query reports %d workgroups per CU\n", per_cu);
        (void)hipGetLastError();
        if (cus * pg8::GIDX_UNITS < NE * (ROWS_E / 256) * 8) { fprintf(stderr, "kernel_launch: %d CUs: E1's row-index table is too small\n", cus); grid = -1; return; }
        grid = cus;
    }
    if (grid < 0) return;
    if (hipMemsetAsync((char*)d_ws + WS_CTL, 0, CTL_ZERO_BYTES, stream) != hipSuccess) return;
    Args a{};
    for (int i = 0; i < 29; ++i) a.in[i] = (const float*)d_in[i];
    a.out = (float*)d_out; a.ws = (unsigned char*)d_ws;
#if MK_MULTI
    for (int p = 0; p < NPH; ++p) { a.ph_lo = p; a.ph_hi = p + 1; hipLaunchKernelGGL(mk_fwd, dim3(grid), dim3(512), LDS_BYTES, stream, a); }
#else
    a.ph_lo = 0; a.ph_hi = NPH; hipLaunchKernelGGL(mk_fwd, dim3(grid), dim3(512), LDS_BYTES, stream, a);
#endif
    const hipError_t le = hipPeekAtLastError();
    if (le != hipSuccess) fprintf(stderr, "kernel_launch: launch failed: %s\n", hipGetErrorName(le));
}
```

```cpp
#include <hip/hip_runtime.h>
#include <cstdio>
#include <cstdint>

#ifndef MK_MULTI
#define MK_MULTI 0
#endif

#define LAS __attribute__((address_space(3)))
#define GAS __attribute__((address_space(1)))
typedef unsigned short bf16_t;
typedef short bf16x8 __attribute__((ext_vector_type(8)));
typedef float f32x4 __attribute__((ext_vector_type(4)));
typedef float f32x2 __attribute__((ext_vector_type(2)));
typedef unsigned u32x4 __attribute__((ext_vector_type(4)));
typedef unsigned u32x2 __attribute__((ext_vector_type(2)));

constexpr int D = 2048, NB = 8, LX = 2048, LC = 256;
constexpr int TX = NB * LX, TC = NB * LC, TT = TX + TC;
constexpr int NIN = 7168;
constexpr int HGW = 5120;
constexpr int NE = 16, FF = 1024, CAPX = 256, CAPC = 32, ROWS_E = NB * (CAPX + CAPC);
constexpr int MODW = 6 * D;
constexpr float EPS = 1e-6f;
constexpr int KRX_LD = 2 * LX + 8, KRC_LD = 2 * LC + 8;

constexpr size_t MiB = 1u << 20;
constexpr size_t WS_CTL = 0, CTL_ZERO_BYTES = 1 * MiB;
constexpr size_t WS_MOD = 1 * MiB;
constexpr size_t WS_DFTX = 2 * MiB;
constexpr size_t WS_DFTC = WS_DFTX + 16 * MiB;
constexpr size_t WS_KRX = WS_DFTC + 1 * MiB;
constexpr size_t WS_KRC = WS_KRX + 9 * MiB;
constexpr size_t WS_AFF = WS_KRC + 2 * MiB;
constexpr size_t WS_SLOT = WS_AFF + 2 * MiB;
constexpr size_t WS_IDX = WS_SLOT + 2 * MiB;
constexpr size_t WS_GATE = WS_IDX + 1 * MiB;
constexpr size_t WS_WIN = WS_GATE + 1 * MiB;
constexpr size_t WIN_BYTES = (size_t)NIN * D * 2;
constexpr size_t WS_WOUT = WS_WIN + 2 * WIN_BYTES;
constexpr size_t WOUT_BYTES = (size_t)D * D * 2;
constexpr size_t WS_WGU = WS_WOUT + 2 * WOUT_BYTES;
constexpr size_t WGU_BYTES = (size_t)NE * 2 * FF * D * 2;
constexpr size_t WS_WD = WS_WGU + 2 * WGU_BYTES;
constexpr size_t WD_BYTES = (size_t)NE * D * FF * 2;
constexpr size_t WS_XCUR = WS_WD + 2 * WD_BYTES;
constexpr size_t WS_XM = WS_XCUR + (size_t)TT * D * 2;
constexpr size_t WS_OVL = WS_XM + (size_t)TT * D * 2;
constexpr size_t WS_FTX = WS_OVL;
constexpr size_t WS_FTC = WS_FTX + (size_t)NB * 512 * 4096 * 2;
constexpr size_t WS_HTX = WS_FTC + (size_t)NB * 512 * 512 * 2;
constexpr size_t WS_HTC = WS_HTX + (size_t)NB * 1536 * LX * 2;
constexpr size_t WS_HG = WS_HTC + (size_t)NB * 1536 * LC * 2;
constexpr size_t WS_OF = WS_HG + (size_t)TT * HGW * 2;
constexpr size_t WS_OB = WS_OF + (size_t)TT * 1024 * 2;
constexpr size_t WS_MIX = WS_OB + (size_t)TT * 1024 * 2;
constexpr size_t WS_END_MIXER = WS_MIX + (size_t)TT * D * 2;
constexpr size_t WS_XS = WS_OVL;
constexpr size_t WS_HID = WS_XS + (size_t)NE * ROWS_E * D * 2;
constexpr size_t WS_Y = WS_HID + (size_t)NE * ROWS_E * FF * 2;
constexpr size_t WS_END_MOE = WS_Y + (size_t)NE * ROWS_E * D * 2;
constexpr size_t WS_END = WS_END_MIXER > WS_END_MOE ? WS_END_MIXER : WS_END_MOE;

constexpr int CW_BAR = 4096;
constexpr int CW_QUEUE = 16384;

constexpr int LDS_BYTES = 163840;
constexpr int LDS_CTL = LDS_BYTES - 256;

__device__ __forceinline__ unsigned f2bf(float f) { unsigned u = __builtin_bit_cast(unsigned, f); return (u + 0x7fffu + ((u >> 16) & 1u)) >> 16; }
typedef __bf16 bf16x2_t __attribute__((ext_vector_type(2)));
__device__ __forceinline__ unsigned pk2(float lo, float hi) { const f32x2 v = {lo, hi}; return __builtin_bit_cast(unsigned, __builtin_convertvector(v, bf16x2_t)); }
__device__ __forceinline__ float bf2f(unsigned short h) { return __builtin_bit_cast(float, (unsigned)h << 16); }
__device__ __forceinline__ float bflo(unsigned w) { return __builtin_bit_cast(float, w << 16); }
__device__ __forceinline__ float bfhi(unsigned w) { return __builtin_bit_cast(float, w & 0xffff0000u); }
__device__ __forceinline__ float shx(float v, int mask, int lane) { return __builtin_bit_cast(float, __builtin_amdgcn_ds_bpermute((lane ^ mask) << 2, __builtin_bit_cast(int, v))); }
__device__ __forceinline__ float wave_sum(float v, int lane) {
#pragma unroll
    for (int o = 1; o < 64; o <<= 1) v += shx(v, o, lane);
    return v;
}
__device__ __forceinline__ float sigmoidf_(float z) { return __builtin_amdgcn_rcpf(1.0f + __builtin_amdgcn_exp2f(-1.44269504089f * z)); }
__device__ __forceinline__ int opaque(int v) { asm volatile("" : "+v"(v)); return v; }
__device__ __forceinline__ int lane_id_() { int v; asm volatile("v_mbcnt_lo_u32_b32 %0, -1, 0\n\tv_mbcnt_hi_u32_b32 %0, -1, %0" : "=v"(v)); return v; }
#define TIDX(a) (((a).wv << 6) | lane_id_())
#define LDS_WAIT() asm volatile("s_waitcnt lgkmcnt(0)" ::: "memory")

#define XB_TMO      128
#define XB_XCNT(j)  (256  + 64 * (j))
#define XB_XSUB(j)  (1280 + 64 * (j))
#define XB_XGEN(j)  (2304 + 64 * (j))
#define XB_TOP      3328
#define XB_TOPGEN   3392
#define XCD_BAR_WORDS 3456
#define XB_SPIN_CAP (1u << 18)
__device__ __forceinline__ unsigned xb_ld(unsigned* p)              { return __hip_atomic_load(p, __ATOMIC_RELAXED, __HIP_MEMORY_SCOPE_AGENT); }
__device__ __forceinline__ unsigned xb_add(unsigned* p, unsigned v) { return __hip_atomic_fetch_add(p, v, __ATOMIC_RELAXED, __HIP_MEMORY_SCOPE_AGENT); }
__device__ __forceinline__ unsigned xb_xcc_id() { return (unsigned)__builtin_amdgcn_s_getreg((3 << 11) | 20) & 0xFu; }
#define XB_SPIN(cond, bar) do { unsigned _sp = 0; while (cond) { __builtin_amdgcn_s_sleep(1); \
    if ((++_sp & 255u) == 0u) { if (xb_ld(&(bar)[XB_TMO])) break; if (_sp > XB_SPIN_CAP) { atomicAdd(&(bar)[XB_TMO], 1u); break; } } } } while (0)
struct XcdBarrier { unsigned* bar; unsigned x; volatile LAS unsigned* st; int wv; };
__device__ __forceinline__ XcdBarrier xcd_barrier_post(unsigned* bar, volatile LAS unsigned* st, int wv) {
    XcdBarrier b; b.bar = bar; b.x = xb_xcc_id(); b.st = st; b.wv = wv;
    if (wv == 0 && lane_id_() == 0) (void)xb_add(&bar[XB_XCNT(b.x)], 1u);
    return b;
}
__device__ __forceinline__ void xcd_barrier_complete(unsigned* bar, unsigned x, unsigned& nloc, unsigned& nx) {
    const unsigned G = gridDim.x * gridDim.y * gridDim.z;
    unsigned sum, cnt, mine, sp = 0u;
    for (;;) {
        sum = 0u; cnt = 0u; mine = 0u;
#pragma unroll
        for (unsigned j = 0; j < 16; ++j) { const unsigned c = xb_ld(&bar[XB_XCNT(j)]); sum += c; cnt += (c > 0u) ? 1u : 0u; mine = (j == x) ? c : mine; }
        if (sum == G) break;
        __builtin_amdgcn_s_sleep(1);
        if ((++sp & 255u) == 0u) { if (xb_ld(&bar[XB_TMO])) break; if (sp > XB_SPIN_CAP) { atomicAdd(&bar[XB_TMO], 1u); break; } }
    }
    nloc = mine > 0u ? mine : 1u; nx = cnt > 0u ? cnt : 1u;
}
__device__ __forceinline__ void xcd_barrier(const XcdBarrier& b) {
    asm volatile("s_waitcnt vmcnt(0)" ::: "memory");
    __syncthreads();
    if (b.wv == 0 && lane_id_() == 0) {
        unsigned* bar = b.bar; asm volatile("" : "+s"(bar));
        __builtin_amdgcn_s_waitcnt(0);
        unsigned nloc = b.st[0], nx = b.st[1];
        if (nloc == 0u) { xcd_barrier_complete(bar, b.x, nloc, nx); b.st[0] = nloc; b.st[1] = nx; }
        const unsigned old = xb_add(&bar[XB_XSUB(b.x)], 1u);
        const unsigned gen = old / nloc;
        if (old + 1u == (gen + 1u) * nloc) {
            __builtin_amdgcn_fence(__ATOMIC_RELEASE, "agent");
            asm volatile("s_waitcnt vmcnt(0)" ::: "memory");
            const unsigned og = xb_add(&bar[XB_TOP], 1u);
            const unsigned tg = og / nx;
            if (og + 1u == (tg + 1u) * nx) xb_add(&bar[XB_TOPGEN], 1u);
            else XB_SPIN(xb_ld(&bar[XB_TOPGEN]) == tg, bar);
            __builtin_amdgcn_fence(__ATOMIC_ACQUIRE, "agent");
            xb_add(&bar[XB_XGEN(b.x)], 1u);
            asm volatile("s_waitcnt vmcnt(0)" ::: "memory");
        } else {
            XB_SPIN(xb_ld(&bar[XB_XGEN(b.x)]) == gen, bar);
            __builtin_amdgcn_fence(__ATOMIC_ACQUIRE, "agent");
            asm volatile("s_waitcnt vmcnt(0)" ::: "memory");
        }
    }
    __syncthreads();
}

#ifndef KLOOP_V
#define KLOOP_V 0
#endif
namespace pg8 {
constexpr int BM = 256, BK = 64, HALF = 128, HTB = HALF * BK * 2, STAGE_BYTES = 8 * HTB, NXCD = 8, WGM = 4;
constexpr int GIDX_UNITS = 5;
constexpr int EPI_SCR = STAGE_BYTES + GIDX_UNITS * 1024, EPI_RS = 144, EPI_WSZ = 16 * EPI_RS;
static_assert(EPI_SCR + 8 * EPI_WSZ <= LDS_CTL, "epilogue scratch");
__host__ __device__ __forceinline__ int lds_byte(int r, int c) { const int x = r & 7; return (r >> 3) * 1024 + x * 128 + (((c >> 3) ^ (x & 6)) << 4) + (c & 7) * 2; }
__host__ __device__ __forceinline__ void stage_rc(int b, int& R, int& C) { const int st = b / 1024, sb = b % 1024, x = sb / 128, cp = (sb % 128) / 16; R = st * 8 + x; C = ((cp ^ (x & 6)) << 3) + (sb % 16) / 2; }
struct Unit { const char* A; const char* B; int pm, pn, aux; };
__device__ __forceinline__ void tile_of(int L, int nM, int nN, int& pm, int& pn) {
    const int nwg = nM * nN; int wgid = L;
    { const int q = nwg / NXCD, r = nwg % NXCD, xcd = wgid % NXCD, off = wgid / NXCD; wgid = (xcd < r ? xcd * (q + 1) : r * (q + 1) + (xcd - r) * q) + off; }
    const int nig = WGM * nN, gid = wgid / nig, fm = gid * WGM, gsz = (nM - fm) < WGM ? (nM - fm) : WGM;
    pm = fm + ((wgid % nig) % gsz); pn = (wgid % nig) / gsz;
}
template <class Epi, class Sched, bool ALIGN_EPI = true, bool SP2 = true, bool GATHER = false, bool PERMB = true, bool BLOCKA = false>
__device__ __forceinline__ void gemm_phase(LAS unsigned char* lds, const int lda, const int ldb, const int K, const Sched& S, const Epi& E, const int wv, const LAS int* gidx = nullptr) {
    const int tid = opaque((wv << 6) | lane_id_()), wid = __builtin_amdgcn_readfirstlane(tid >> 6), lane = tid & 63, wr = wid >> 2, wc = wid & 3, fr = lane & 15, fq = lane >> 4;
    const int nt = K / BK;
    int sR[2], sC[2];
    unsigned vA[2][2], vN[2][2], voffB[2];
#pragma unroll
    for (int i = 0; i < 2; ++i) { stage_rc(tid * 16 + i * 8192, sR[i], sC[i]); voffB[i] = (unsigned)((PERMB ? 64 * (sR[i] >> 5) + (sR[i] & 31) : sR[i]) * ldb + sC[i]) * 2u; }
    const size_t kstep = (size_t)(BK * 2);
    const size_t hstepB = (size_t)(PERMB ? 32 : HALF) * ldb * 2;
    LAS unsigned char* const escr = lds + EPI_SCR + wid * EPI_WSZ;
    const unsigned ldsw = (unsigned)wid * 1024u;
    const int aoff[2] = {lds_byte(wr * 64 + fr, fq * 8), lds_byte(wr * 64 + fr, 32 + fq * 8)}, boff[2] = {lds_byte(wc * 32 + fr, fq * 8), lds_byte(wc * 32 + fr, 32 + fq * 8)};
#define PG8_SA(b, h) (((b) * 2 + (h)) * HTB)
#define PG8_SB(b, h) ((4 + (b) * 2 + (h)) * HTB)
#ifndef B_AUX
#define B_AUX 0
#endif
#define PG8_STAGE_X(bufoff, gbase, voff, aux) do { _Pragma("unroll") for (int _i = 0; _i < 2; ++_i) \
        __builtin_amdgcn_global_load_lds((const unsigned*)((const char*)(gbase) + (voff)[_i]), (LAS unsigned*)(lds + (bufoff) + ldsw + _i * 8192), 16, 0, aux); } while (0)
#define PG8_STAGE(bufoff, gbase, voff) PG8_STAGE_X(bufoff, gbase, voff, 0)
#define PG8_VOFF(dst, slot) do { _Pragma("unroll") for (int _h = 0; _h < 2; ++_h) _Pragma("unroll") for (int _i = 0; _i < 2; ++_i) \
        dst[_h][_i] = GATHER ? ((unsigned)gidx[(slot) * 256 + _h * HALF + sR[_i]] * (unsigned)lda + (unsigned)sC[_i]) * 2u : (unsigned)((_h * HALF + sR[_i]) * lda + sC[_i]) * 2u; } while (0)
#define PG8_LDA(dst, b, h) do { _Pragma("unroll") for (int m = 0; m < 4; ++m) _Pragma("unroll") for (int k = 0; k < 2; ++k) dst[m][k] = *(const LAS bf16x8*)(lds + PG8_SA(b, h) + aoff[k] + m * 2048); } while (0)
#define PG8_LDB(dst, b, h) do { _Pragma("unroll") for (int n = 0; n < 2; ++n) _Pragma("unroll") for (int k = 0; k < 2; ++k) dst[n][k] = *(const LAS bf16x8*)(lds + PG8_SB(b, h) + boff[k] + n * 2048); } while (0)
#define PG8_MMA(ai, bj, At, Bt) do { __builtin_amdgcn_s_setprio(1); _Pragma("unroll") for (int m = 0; m < 4; ++m) _Pragma("unroll") for (int n = 0; n < 2; ++n) _Pragma("unroll") for (int k = 0; k < 2; ++k) \
        acc[ai][bj][m][n] = __builtin_amdgcn_mfma_f32_16x16x32_bf16(Bt[n][k], At[m][k], acc[ai][bj][m][n], 0, 0, 0); __builtin_amdgcn_s_setprio(0); } while (0)
#define PG8_WAIT_V(n) asm volatile("s_waitcnt vmcnt(" #n ")" ::: "memory")
#define PG8_WAIT_L(n) asm volatile("s_waitcnt lgkmcnt(" #n ")" ::: "memory")
#define PG8_BAR __builtin_amdgcn_s_barrier()
#define PG8_SCHED __builtin_amdgcn_sched_barrier(0)
    Unit cur, nxt; int ui = 0;
    if (!S.next(0, cur)) return;
    f32x4 acc[2][2][4][2];
#pragma unroll
    for (int a = 0; a < 2; ++a)
#pragma unroll
        for (int b = 0; b < 2; ++b)
#pragma unroll
            for (int m = 0; m < 4; ++m)
#pragma unroll
                for (int n = 0; n < 2; ++n) acc[a][b][m][n] = (f32x4){0.f, 0.f, 0.f, 0.f};
    bf16x8 At[4][2], B0[2][2], B1[2][2];
    const char* cA = cur.A; const char* cB = cur.B;
    PG8_VOFF(vA, 0);
    if constexpr (SP2) {
        PG8_STAGE_X(PG8_SB(0, 0), cB, voffB, B_AUX); PG8_STAGE_X(PG8_SB(0, 1), cB + hstepB, voffB, B_AUX); PG8_STAGE(PG8_SA(0, 0), cA, vA[0]); PG8_STAGE(PG8_SA(0, 1), cA, vA[1]);
        if (wr == 1) PG8_BAR;
        PG8_WAIT_V(2); PG8_BAR;
        PG8_STAGE_X(PG8_SB(1, 0), cB + kstep, voffB, B_AUX); PG8_STAGE(PG8_SA(1, 0), cA + kstep, vA[0]); PG8_STAGE_X(PG8_SB(1, 1), cB + hstepB + kstep, voffB, B_AUX);
        PG8_WAIT_V(6); PG8_BAR;
    } else {
        PG8_STAGE_X(PG8_SB(0, 0), cB, voffB, B_AUX); PG8_STAGE(PG8_SA(0, 0), cA, vA[0]); PG8_STAGE_X(PG8_SB(0, 1), cB + hstepB, voffB, B_AUX); PG8_STAGE(PG8_SA(0, 1), cA, vA[1]);
        if (wr == 1) PG8_BAR;
        PG8_WAIT_V(4); PG8_BAR;
        PG8_STAGE_X(PG8_SB(1, 0), cB + kstep, voffB, B_AUX); PG8_STAGE(PG8_SA(1, 0), cA + kstep, vA[0]); PG8_STAGE_X(PG8_SB(1, 1), cB + hstepB + kstep, voffB, B_AUX);
        PG8_WAIT_V(6); PG8_BAR;
    }
    for (;;) {
        const bool has_next = S.next(ui + 1, nxt);
        const char* nA = has_next ? nxt.A : cA; const char* nB = has_next ? nxt.B : cB;
        if (GATHER && has_next) { PG8_VOFF(vN, ui + 1); }
        else {
#pragma unroll
            for (int h = 0; h < 2; ++h) { vN[h][0] = vA[h][0]; vN[h][1] = vA[h][1]; } }
        for (int t = 0; t < nt; t += 2) {
            const bool last = (t == nt - 2);
            const char* a1 = BLOCKA ? cA + (size_t)(t >> 1) * 65536 + 128 : cA + (size_t)(t + 1) * kstep;
            const char* a2 = last ? nA : (BLOCKA ? cA + (size_t)((t + 2) >> 1) * 65536 : cA + (size_t)(t + 2) * kstep); const char* b2 = last ? nB : cB + (size_t)(t + 2) * kstep;
            const char* a3 = a2 + kstep; const char* b3 = b2 + kstep;
            unsigned v2[2][2];
#pragma unroll
            for (int h = 0; h < 2; ++h) { v2[h][0] = (GATHER && last) ? vN[h][0] : vA[h][0]; v2[h][1] = (GATHER && last) ? vN[h][1] : vA[h][1]; }
            if constexpr (SP2) {
            PG8_LDB(B0, 0, 0); PG8_LDB(B1, 0, 1); PG8_SCHED; PG8_LDA(At, 0, 0); PG8_STAGE(PG8_SA(1, 1), a1, vA[1]);
            PG8_WAIT_V(8); PG8_WAIT_L(0); PG8_BAR; PG8_MMA(0, 0, At, B0); PG8_MMA(0, 1, At, B1); PG8_BAR; PG8_SCHED;
#if KLOOP_V == 1
            PG8_LDA(At, 0, 1); PG8_STAGE_X(PG8_SB(0, 0), b2, voffB, B_AUX);
            PG8_WAIT_V(4); PG8_WAIT_L(0); PG8_BAR; PG8_MMA(1, 0, At, B0); PG8_SCHED; PG8_STAGE_X(PG8_SB(0, 1), b2 + hstepB, voffB, B_AUX); PG8_STAGE(PG8_SA(0, 0), a2, v2[0]); PG8_SCHED; PG8_MMA(1, 1, At, B1); PG8_BAR; PG8_SCHED;
#else
            PG8_LDA(At, 0, 1); PG8_STAGE_X(PG8_SB(0, 0), b2, voffB, B_AUX); PG8_STAGE_X(PG8_SB(0, 1), b2 + hstepB, voffB, B_AUX); PG8_STAGE(PG8_SA(0, 0), a2, v2[0]);
            PG8_WAIT_V(8); PG8_WAIT_L(0); PG8_BAR; PG8_MMA(1, 0, At, B0); PG8_MMA(1, 1, At, B1); PG8_BAR; PG8_SCHED;
#endif
            PG8_LDB(B0, 1, 0); PG8_LDB(B1, 1, 1); PG8_SCHED; PG8_LDA(At, 1, 0); PG8_STAGE(PG8_SA(0, 1), a2, v2[1]);
            PG8_WAIT_V(8); PG8_WAIT_L(0); PG8_BAR; PG8_MMA(0, 0, At, B0); PG8_MMA(0, 1, At, B1); PG8_BAR; PG8_SCHED;
#if KLOOP_V == 1
            PG8_LDA(At, 1, 1); PG8_STAGE_X(PG8_SB(1, 0), b3, voffB, B_AUX);
            PG8_WAIT_V(4); PG8_WAIT_L(0); PG8_BAR; PG8_MMA(1, 0, At, B0); PG8_SCHED; PG8_STAGE_X(PG8_SB(1, 1), b3 + hstepB, voffB, B_AUX); PG8_STAGE(PG8_SA(1, 0), a3, v2[0]); PG8_SCHED; PG8_MMA(1, 1, At, B1); PG8_BAR; PG8_SCHED;
#else
            PG8_LDA(At, 1, 1); PG8_STAGE_X(PG8_SB(1, 0), b3, voffB, B_AUX); PG8_STAGE_X(PG8_SB(1, 1), b3 + hstepB, voffB, B_AUX); PG8_STAGE(PG8_SA(1, 0), a3, v2[0]);
            PG8_WAIT_V(8); PG8_WAIT_L(0); PG8_BAR; PG8_MMA(1, 0, At, B0); PG8_MMA(1, 1, At, B1); PG8_BAR; PG8_SCHED;
#endif
            } else {
            PG8_LDB(B0, 0, 0); PG8_SCHED; PG8_LDA(At, 0, 0); PG8_STAGE(PG8_SA(1, 1), a1, vA[1]);
            PG8_WAIT_L(8); PG8_BAR; PG8_WAIT_L(0); PG8_MMA(0, 0, At, B0); PG8_BAR; PG8_SCHED;
            PG8_LDB(B1, 0, 1); PG8_STAGE_X(PG8_SB(0, 0), b2, voffB, B_AUX);
            PG8_BAR; PG8_WAIT_L(0); PG8_MMA(0, 1, At, B1); PG8_BAR;
            PG8_LDA(At, 0, 1); PG8_STAGE(PG8_SA(0, 0), a2, v2[0]);
            PG8_BAR; PG8_WAIT_L(0); PG8_MMA(1, 0, At, B0); PG8_BAR; PG8_SCHED;
            PG8_STAGE_X(PG8_SB(0, 1), b2 + hstepB, voffB, B_AUX);
            PG8_WAIT_V(6); PG8_BAR; PG8_MMA(1, 1, At, B1); PG8_BAR;
            PG8_LDB(B0, 1, 0); PG8_SCHED; PG8_LDA(At, 1, 0); PG8_STAGE(PG8_SA(0, 1), a2, v2[1]);
            PG8_WAIT_L(8); PG8_BAR; PG8_WAIT_L(0); PG8_MMA(0, 0, At, B0); PG8_BAR; PG8_SCHED;
            PG8_LDB(B1, 1, 1); PG8_STAGE_X(PG8_SB(1, 0), b3, voffB, B_AUX);
            PG8_BAR; PG8_WAIT_L(0); PG8_MMA(0, 1, At, B1); PG8_BAR;
            PG8_LDA(At, 1, 1); PG8_STAGE(PG8_SA(1, 0), a3, v2[0]);
            PG8_BAR; PG8_WAIT_L(0); PG8_MMA(1, 0, At, B0); PG8_BAR; PG8_SCHED;
            PG8_STAGE_X(PG8_SB(1, 1), b3 + hstepB, voffB, B_AUX);
            PG8_WAIT_V(6); PG8_BAR; PG8_MMA(1, 1, At, B1); PG8_BAR;
            }
        }
        if constexpr (ALIGN_EPI) { if (wr == 0) PG8_BAR; }
        E(acc, cur, wr, wc, fr, fq, escr);
#if defined(EPI_REP) && EPI_REP
        if constexpr (Epi::IDEM) E(acc, cur, wr, wc, fr, fq, escr);
#endif
        if (!has_next) break;
#pragma unroll
        for (int a = 0; a < 2; ++a)
#pragma unroll
            for (int b = 0; b < 2; ++b)
#pragma unroll
                for (int m = 0; m < 4; ++m)
#pragma unroll
                    for (int n = 0; n < 2; ++n) acc[a][b][m][n] = (f32x4){0.f, 0.f, 0.f, 0.f};
        cur = nxt; cA = nA; cB = nB; ++ui;
#pragma unroll
        for (int h = 0; h < 2; ++h) { vA[h][0] = vN[h][0]; vA[h][1] = vN[h][1]; }
        if constexpr (ALIGN_EPI) { if (wr == 1) PG8_BAR; }
    }
    PG8_WAIT_V(0);
    if constexpr (!ALIGN_EPI) { if (wr == 0) PG8_BAR; }
    PG8_BAR;
#undef PG8_SA
#undef PG8_SB
#undef PG8_STAGE
#undef PG8_STAGE_X
#undef PG8_VOFF
#undef PG8_LDA
#undef PG8_LDB
#undef PG8_MMA
#undef PG8_WAIT_V
#undef PG8_WAIT_L
#undef PG8_BAR
#undef PG8_SCHED
}
}
using pg8::Unit;

struct Args { const float* in[29]; float* out; unsigned char* ws; int ph_lo, ph_hi, wv; };
enum { I_X = 0, I_C, I_CTX, I_CCTX, I_NMIX, I_NFFN, I_NFIN, I_WMOD, I_BMOD, I_WIN, I_WOUT, I_WFNET, I_HCW, I_HCB, I_HW1, I_HB1, I_HW2, I_HB2, I_HW3, I_HB3, I_HWO, I_HFREQ, I_HBIAS, I_HGLB, I_HGNG, I_WR, I_WG, I_WU, I_WDN };

#define WSP(T, off) ((T*)(a.ws + (off)))

__device__ __forceinline__ int mrow_of(int row) { return row < TX ? (row >> 11) : 8; }

__device__ __forceinline__ void transpose_item(const float* src, int ld_src, int k0, int n0, bf16_t* dst, int ldd, int dst_row0, LAS float* scr, int lane) {
    float tv[32];
#pragma unroll
    for (int i = 0; i < 32; ++i) tv[i] = src[(size_t)(k0 + 2 * i + (lane >> 5)) * ld_src + n0 + (lane & 31)];
#pragma unroll
    for (int i = 0; i < 32; ++i) scr[(2 * i + (lane >> 5)) * 33 + (lane & 31)] = tv[i];
    LDS_WAIT(); asm volatile("" ::: "memory");
    const int c = lane & 7;
#pragma unroll
    for (int j = 0; j < 4; ++j) { const int n = (lane >> 3) + 8 * j; const LAS float* s = scr + (8 * c) * 33 + n;
        u32x4 o; o.x = pk2(s[0 * 33], s[1 * 33]); o.y = pk2(s[2 * 33], s[3 * 33]); o.z = pk2(s[4 * 33], s[5 * 33]); o.w = pk2(s[6 * 33], s[7 * 33]);
        *(u32x4*)(dst + (size_t)(dst_row0 + n) * ldd + k0 + 8 * c) = o; }
    LDS_WAIT(); asm volatile("" ::: "memory");
}

#ifndef P0_REP
#define P0_REP 0
#endif
constexpr int BGL_GU0 = 32768, BGL_DN0 = BGL_GU0 + 16384, BGL_IN1 = BGL_DN0 + 32 * 208, BGL_OUT1 = BGL_IN1 + 24 * 64, BGL_GU1 = BGL_OUT1 + 32768, BGL_TOTAL = BGL_GU1 + 16384;
#ifndef TAIL_G1
#define TAIL_G1 18
#define TAIL_G2 18
#define TAIL_E1 14
#define TAIL_E2 8
#endif
#ifndef TAIL_M0
#define TAIL_M0 14
#define TAIL_M1 20
#endif
constexpr int TAILC_G1 = 32 * 8 * TAIL_G1, TAILC_M0 = 128 * 8 * TAIL_M0, TAILC_G2 = 192 * 8 * TAIL_G2, TAILC_E1 = 128 * 8 * TAIL_E1, TAILC_E2 = 128 * 8 * TAIL_E2, TAILC_G1L1 = 160 * 8 * 16, TAILC_M1 = 128 * 8 * TAIL_M1;
constexpr int TS_G1 = 0, TS_M0 = TS_G1 + TAILC_G1, TS_G2 = TS_M0 + TAILC_M0, TS_E1 = TS_G2 + TAILC_G2, TS_E2 = TS_E1 + TAILC_E1, TS_G1L1 = TS_E2 + TAILC_E2, TS_M1 = TS_G1L1 + TAILC_G1L1, TS_END = TS_M1 + TAILC_M1;
constexpr int TAIL_IN_PHASES = TS_END < BGL_TOTAL ? TS_END : BGL_TOTAL;
static_assert(TS_E1 >= BGL_GU0, "layer 0's gate | up weights must be complete before E1(0)");
static_assert(TS_E2 >= BGL_DN0, "layer 0's down weights must be complete before E2(0)");
static_assert(TS_G1L1 >= BGL_IN1, "layer 1's w_in must be complete before G1(1)");
static_assert(TS_M1 >= BGL_OUT1, "layer 1's w_out must be complete before G2(1)");
__device__ __forceinline__ void bgl_tile(const Args& a, int r, LAS float* scr, int lane) {
    if (r < BGL_GU0 || (r >= BGL_OUT1 && r < BGL_GU1)) { const int l = r >= BGL_OUT1 ? 1 : 0; const int r1 = l ? r - BGL_OUT1 : r, up = r1 >> 14, rr = r1 & 16383, e = rr / 1024, q = rr % 1024, kb = q / 32, nb = q % 32, n0 = 32 * nb;
        transpose_item(a.in[up ? I_WU : I_WG] + ((size_t)l * NE + e) * D * FF, FF, 64 * kb, n0, WSP(bf16_t, WS_WGU + l * WGU_BYTES) + (size_t)e * 2 * FF * D, D, 256 * (n0 >> 7) + (n0 & 127) + (up ? 128 : 0), scr, lane); }
    else if (r < BGL_DN0 || r >= BGL_GU1) { const int l = r >= BGL_GU1 ? 1 : 0; const int rr = l ? r - BGL_GU1 : r - BGL_GU0, e = rr / 1024, q = rr % 1024, kb = q / 64, nb = q % 64;
        transpose_item(a.in[I_WDN] + ((size_t)l * NE + e) * FF * D, D, 64 * kb, 32 * nb, WSP(bf16_t, WS_WD + l * WD_BYTES) + (size_t)e * D * FF, FF, 32 * nb, scr, lane); }
    else if (r < BGL_IN1) { const int rr = r - BGL_DN0, kb = rr / 208, nb = rr % 208;
        transpose_item(a.in[I_WIN] + (size_t)D * 7168, 7168, 64 * kb, 512 + 32 * nb, WSP(bf16_t, WS_WIN + WIN_BYTES), D, 512 + 32 * nb, scr, lane); }
    else { const int rr = r - BGL_IN1, kb = rr / 64, nb = rr % 64;
        transpose_item(a.in[I_WOUT] + (size_t)D * D, D, 512 + 64 * kb, 32 * nb, WSP(bf16_t, WS_WOUT + WOUT_BYTES), D, 32 * nb, scr, lane); }
}
__device__ __forceinline__ void tail_copy(const Args& a, LAS unsigned char* lds, int first, int count, int rank, int nranks) {
    const int tid = opaque(TIDX(a)), lane = tid & 63, wave = __builtin_amdgcn_readfirstlane(tid >> 6);
    LAS float* scr = (LAS float*)(lds + wave * 16384);
    const int last = (first + count < TAIL_IN_PHASES) ? first + count : TAIL_IN_PHASES;
    for (int r = first + rank * 8 + wave; r < last; r += nranks * 8) bgl_tile(a, r, scr, lane);
}
__device__ __forceinline__ void p0_prologue(const Args& a, LAS unsigned char* lds, int bid, int G) {
    const int tid = opaque(TIDX(a)), lane = tid & 63, wave = __builtin_amdgcn_readfirstlane(tid >> 6);
    _Pragma("unroll") for (int p0r_ = 0; p0r_ < 1 + ((P0_REP >> 0) & 1); ++p0r_)
    {
        LAS float* sc = (LAS float*)lds;
        LAS float* red = (LAS float*)(lds + 9 * 2048 * 4);
        const float* cin = a.in[I_C]; const float* cc = a.in[I_CCTX];
        for (int i = tid; i < 9 * 2048; i += 512) { const float v = (i < 8 * 2048) ? cin[i] : cc[i - 8 * 2048]; sc[i] = v * sigmoidf_(v); }
        __syncthreads();
        for (int u = bid; u < 192; u += G) {
            const int l = u / 96, j0 = (u % 96) * 128, kb = wave * 256;
            float acc[9][2];
#pragma unroll
            for (int r = 0; r < 9; ++r) { acc[r][0] = 0.f; acc[r][1] = 0.f; }
            const float* wp = a.in[I_WMOD] + (size_t)l * D * MODW + (size_t)kb * MODW + j0 + 2 * lane;
            for (int k = 0; k < 256; k += 16) {
                f32x2 w[16];
#pragma unroll
                for (int q = 0; q < 16; ++q) w[q] = *(const f32x2*)(wp + (size_t)(k + q) * MODW);
#pragma unroll
                for (int q = 0; q < 16; ++q)
#pragma unroll
                    for (int r = 0; r < 9; ++r) { const float sv = sc[r * 2048 + kb + k + q]; acc[r][0] += sv * w[q].x; acc[r][1] += sv * w[q].y; }
            }
#pragma unroll
            for (int r = 0; r < 9; ++r) *(LAS f32x2*)(red + (wave * 9 + r) * 128 + 2 * lane) = (f32x2){acc[r][0], acc[r][1]};
            __syncthreads();
            for (int i = tid; i < 9 * 128; i += 512) { const int r = i >> 7, cn = i & 127; float s2 = 0.f;
#pragma unroll
                for (int w = 0; w < 8; ++w) s2 += red[(w * 9 + r) * 128 + cn];
                WSP(float, WS_MOD)[(size_t)(l * 9 + r) * MODW + j0 + cn] = s2 + a.in[I_BMOD][l * MODW + j0 + cn]; }
            __syncthreads();
        }
    }
    _Pragma("unroll") for (int p0r_ = 0; p0r_ < 1 + ((P0_REP >> 1) & 1); ++p0r_)
    {
        LAS float* scr = (LAS float*)(lds + wave * 16384);
        const int gw = bid * 8 + wave, NGW = G * 8;
        constexpr int I_IN = 32 * 208, I_OUT = 24 * 64, I_L0 = I_IN + I_OUT;
        const int bg0 = (G == 256) ? TAIL_IN_PHASES : 0;
        const int ntot = I_L0 + (BGL_TOTAL - bg0);
        for (int it = gw; it < ntot; it += NGW) {
            int r = it;
            if (r < I_IN) { const int kb = r / 208, nb = r % 208;
                transpose_item(a.in[I_WIN], 7168, 64 * kb, 512 + 32 * nb, WSP(bf16_t, WS_WIN), D, 512 + 32 * nb, scr, lane); continue; }
            r -= I_IN;
            if (r < I_OUT) { const int kb = r / 64, nb = r % 64;
                transpose_item(a.in[I_WOUT], D, 512 + 64 * kb, 32 * nb, WSP(bf16_t, WS_WOUT), D, 32 * nb, scr, lane); continue; }
            r -= I_OUT;
            bgl_tile(a, bg0 + r, scr, lane);
        }
        __syncthreads();
    }
    _Pragma("unroll") for (int p0r_ = 0; p0r_ < 1 + ((P0_REP >> 2) & 1); ++p0r_)
    {
        const int gt = bid * 512 + tid, NT = G * 512;
        for (int g = gt; g < LX * (LX / 8); g += NT) { const int tp = g / (LX / 8), k0 = (g % (LX / 8)) * 8; unsigned w[4];
#pragma unroll
            for (int j = 0; j < 8; j += 2) { float v[2];
#pragma unroll
                for (int q = 0; q < 2; ++q) { const int kk = k0 + j + q; const bool isc = kk <= LX / 2; const int t = isc ? kk : kk - LX / 2; const float ang = (float)((tp * t) & (LX - 1)) * (2.0f / LX);
                    v[q] = (isc ? cospif(ang) : -sinpif(ang)) * (1.0f / 512.0f); }
                w[j >> 1] = pk2(v[0], v[1]); }
            *(u32x4*)(WSP(bf16_t, WS_DFTX) + (size_t)tp * LX + k0) = (u32x4){w[0], w[1], w[2], w[3]}; }
        for (int g = gt; g < LC * (2 * LC / 8); g += NT) { const int tp = g / (2 * LC / 8), k0 = (g % (2 * LC / 8)) * 8; unsigned w[4];
#pragma unroll
            for (int j = 0; j < 8; j += 2) { float v[2];
#pragma unroll
                for (int q = 0; q < 2; ++q) { const int kk = k0 + j + q; const int t = kk & (LC - 1); const float ang = (float)((tp * t) & (LC - 1)) * (2.0f / LC);
                    v[q] = (kk < LC ? cospif(ang) : -sinpif(ang)) * 0.00552427172802f; }
                w[j >> 1] = pk2(v[0], v[1]); }
            *(u32x4*)(WSP(bf16_t, WS_DFTC) + (size_t)tp * (2 * LC) + k0) = (u32x4){w[0], w[1], w[2], w[3]}; }
    }
    _Pragma("unroll") for (int p0r_ = 0; p0r_ < 1 + ((P0_REP >> 3) & 1); ++p0r_)
    {
        LAS float* hz = (LAS float*)lds;
        LAS float* hy = (LAS float*)(lds + 8192);
        LAS float* zf = (LAS float*)(lds + 16384);
        for (int u = bid; u < 2 * 72; u += G) {
            const int l = u / 72, q = u % 72; const bool isx = q < 64; const int L = isx ? LX : LC; const int p0 = (isx ? q : q - 64) * 32;
            __syncthreads();
            for (int idx = tid; idx < 32 * 33; idx += 512) { const int p = idx / 33, j = idx % 33, pos = p0 + p; float v; const float wrev = 2.0f * (float)pos / (float)L;
                if (j == 0) v = (float)pos / (float)(L - 1);
                else { const int bi = (j - 1) & 15; const float band = 1e-4f + (float)bi * ((15.0f - 1e-4f) / 15.0f); v = (j <= 16) ? cospif(band * wrev) : -sinpif(band * wrev); }
                zf[p * 36 + j] = v; }
            __syncthreads();
            const int j = tid & 63, pg = tid >> 6;
            { float s4[4]; const float bb = a.in[I_HB1][l * 64 + j]; const float* w1 = a.in[I_HW1] + l * 33 * 64;
#pragma unroll
                for (int qq = 0; qq < 4; ++qq) s4[qq] = bb;
                for (int m = 0; m < 33; ++m) { const float w = w1[m * 64 + j];
#pragma unroll
                    for (int qq = 0; qq < 4; ++qq) s4[qq] += zf[(4 * pg + qq) * 36 + m] * w; }
                const float fr = a.in[I_HFREQ][(l * 3 + 0) * 64 + j] * 0.318309886184f;
#pragma unroll
                for (int qq = 0; qq < 4; ++qq) hz[(4 * pg + qq) * 64 + j] = sinpif(fr * s4[qq]); }
            __syncthreads();
            { float s4[4]; const float bb = a.in[I_HB2][l * 64 + j]; const float* w2 = a.in[I_HW2] + l * 64 * 64;
#pragma unroll
                for (int qq = 0; qq < 4; ++qq) s4[qq] = bb;
                for (int m = 0; m < 64; ++m) { const float w = w2[m * 64 + j];
#pragma unroll
                    for (int qq = 0; qq < 4; ++qq) s4[qq] += hz[(4 * pg + qq) * 64 + m] * w; }
                const float fr = a.in[I_HFREQ][(l * 3 + 1) * 64 + j] * 0.318309886184f;
#pragma unroll
                for (int qq = 0; qq < 4; ++qq) hy[(4 * pg + qq) * 64 + j] = sinpif(fr * s4[qq]); }
            __syncthreads();
            { float s4[4]; const float bb = a.in[I_HB3][l * 64 + j]; const float* w3 = a.in[I_HW3] + l * 64 * 64;
#pragma unroll
                for (int qq = 0; qq < 4; ++qq) s4[qq] = bb;
                for (int m = 0; m < 64; ++m) { const float w = w3[m * 64 + j];
#pragma unroll
                    for (int qq = 0; qq < 4; ++qq) s4[qq] += hy[(4 * pg + qq) * 64 + m] * w; }
                const float fr = a.in[I_HFREQ][(l * 3 + 2) * 64 + j] * 0.318309886184f;
#pragma unroll
                for (int qq = 0; qq < 4; ++qq) hz[(4 * pg + qq) * 64 + j] = sinpif(fr * s4[qq]); }
            __syncthreads();
            const float* wo = a.in[I_HWO] + l * 64 * 1024;
            bf16_t* kr = isx ? WSP(bf16_t, WS_KRX) + (size_t)l * 512 * KRX_LD : WSP(bf16_t, WS_KRC) + (size_t)l * 512 * KRC_LD;
            const int ld = isx ? KRX_LD : KRC_LD;
            for (int h = 0; h < 2; ++h) {
                const int n = tid + 512 * h, c = n & 511, dir = n >> 9;
                float w[64];
#pragma unroll
                for (int m = 0; m < 64; ++m) w[m] = wo[m * 1024 + n];
                const float adelta = fabsf(-3.07011346f + (float)c * ((-15.3505673f + 3.07011346f) / 511.0f));
                for (int pp = 0; pp < 32; ++pp) { float acc = 0.f;
#pragma unroll
                    for (int m4 = 0; m4 < 16; ++m4) { const f32x4 hv = *(const LAS f32x4*)(hz + pp * 64 + 4 * m4); acc += hv.x * w[4 * m4] + hv.y * w[4 * m4 + 1] + hv.z * w[4 * m4 + 2] + hv.w * w[4 * m4 + 3]; }
                    const int ps = p0 + pp; const float tn = (float)ps / (float)(L - 1); const float v = acc * __expf(-tn * adelta);
                    if (dir == 0) kr[(size_t)c * ld + (L - ps)] = (bf16_t)f2bf(v);
                    else if (ps >= 1) kr[(size_t)c * ld + (L + ps)] = (bf16_t)f2bf(v); }
                if (p0 == 0 && dir == 0) { kr[(size_t)c * ld] = 0;
#pragma unroll
                    for (int z = 0; z < 8; ++z) kr[(size_t)c * ld + 2 * L + z] = 0; }
            }
        }
        __syncthreads();
    }
    _Pragma("unroll") for (int p0r_ = 0; p0r_ < 1 + ((P0_REP >> 4) & 1); ++p0r_)
    {
        constexpr int TS = 272;
        LAS unsigned char* Tt = lds;
        LAS unsigned char* Bt = lds + 256 * TS;
        const int lr = lane & 15, lq = lane >> 4;
        __syncthreads();
        for (int i = tid; i < 256 * 64; i += 512) { const int np = i >> 6, c = (i & 63) * 2; const int cs = np >> 7, cp = np & 127;
            const float t0 = cospif((float)((c * cp + (cs ? 96 : 0)) & 127) * (1.0f / 64.0f)), t1 = cospif((float)(((c + 1) * cp + (cs ? 96 : 0)) & 127) * (1.0f / 64.0f));
            *(LAS unsigned*)(Tt + np * TS + c * 2) = pk2(t0, t1); }
        for (int u = bid; u < 2 * 256; u += G) {
            const int l = u >> 8, g = (u >> 6) & 3, k0 = (u & 63) * 32;
            __syncthreads();
            { const int kk = tid >> 4, c8 = tid & 15; const float* src = a.in[I_WIN] + (size_t)l * D * 7168 + (size_t)(k0 + kk) * 7168 + g * 128 + 8 * c8;
              const f32x4 v0 = *(const f32x4*)src, v1 = *(const f32x4*)(src + 4);
              *(LAS u32x4*)(Bt + kk * TS + c8 * 16) = (u32x4){pk2(v0.x, v0.y), pk2(v0.z, v0.w), pk2(v1.x, v1.y), pk2(v1.z, v1.w)}; }
            __syncthreads();
            f32x4 acc[2][2];
#pragma unroll
            for (int kt = 0; kt < 2; ++kt) { acc[kt][0] = (f32x4){0.f, 0.f, 0.f, 0.f}; acc[kt][1] = acc[kt][0]; }
#pragma unroll
            for (int ks = 0; ks < 4; ++ks) { bf16x8 af[2], bf[2];
#pragma unroll
                for (int kt = 0; kt < 2; ++kt) af[kt] = *(const LAS bf16x8*)(Bt + (16 * kt + lr) * TS + ks * 64 + lq * 16);
#pragma unroll
                for (int nt = 0; nt < 2; ++nt) bf[nt] = *(const LAS bf16x8*)(Tt + (16 * (2 * wave + nt) + lr) * TS + ks * 64 + lq * 16);
#pragma unroll
                for (int kt = 0; kt < 2; ++kt)
#pragma unroll
                    for (int nt = 0; nt < 2; ++nt) acc[kt][nt] = __builtin_amdgcn_mfma_f32_16x16x32_bf16(af[kt], bf[nt], acc[kt][nt], 0, 0, 0); }
#pragma unroll
            for (int kt = 0; kt < 2; ++kt)
#pragma unroll
                for (int nt = 0; nt < 2; ++nt) { const int np = 16 * (2 * wave + nt) + lr, cs = np >> 7, cp = np & 127; const f32x4 v = acc[kt][nt];
                    if (cs == 0 ? (cp <= 64) : (cp >= 1 && cp <= 63))
                        *(u32x2*)(WSP(bf16_t, WS_WIN + l * WIN_BYTES) + (size_t)(g * 128 + (cs ? 64 + cp : cp)) * D + k0 + 16 * kt + 4 * lq) = (u32x2){pk2(v.x, v.y), pk2(v.z, v.w)}; }
        }
        __syncthreads();
    }
    _Pragma("unroll") for (int p0r_ = 0; p0r_ < 1 + ((P0_REP >> 5) & 1); ++p0r_)
    {
        constexpr int FS = 80;
        LAS unsigned char* At = lds;
        LAS unsigned char* Bt = lds + 64 * FS;
        const int lr = lane & 15, lq = lane >> 4, nt = wave & 3, ih = wave >> 2;
        for (int u = bid; u < 2 * 128; u += G) {
            const int l = u >> 7, n0 = ((u >> 2) & 31) * 64, i0 = (u & 3) * 128;
            f32x4 acc[4];
#pragma unroll
            for (int it = 0; it < 4; ++it) acc[it] = (f32x4){0.f, 0.f, 0.f, 0.f};
            for (int j0 = 0; j0 < 512; j0 += 32) {
                __syncthreads();
#pragma unroll
                for (int q = 0; q < 4; ++q) { const int idx = tid + 512 * q, jj = idx >> 6, nn = idx & 63;
                    *(LAS bf16_t*)(At + nn * FS + jj * 2) = (bf16_t)f2bf(a.in[I_WOUT][(size_t)l * D * D + (size_t)(j0 + jj) * D + n0 + nn]); }
                { const int ii = tid >> 2, c8 = tid & 3; const float* src = a.in[I_WFNET] + (size_t)l * 512 * 512 + (size_t)(i0 + ii) * 512 + j0 + 8 * c8;
                  const f32x4 v0 = *(const f32x4*)src, v1 = *(const f32x4*)(src + 4);
                  *(LAS u32x4*)(Bt + ii * FS + c8 * 16) = (u32x4){pk2(v0.x, v0.y), pk2(v0.z, v0.w), pk2(v1.x, v1.y), pk2(v1.z, v1.w)}; }
                __syncthreads();
                const bf16x8 bfr = *(const LAS bf16x8*)(At + (16 * nt + lr) * FS + lq * 16);
#pragma unroll
                for (int it = 0; it < 4; ++it) { const bf16x8 afr = *(const LAS bf16x8*)(Bt + (64 * ih + 16 * it + lr) * FS + lq * 16);
                    acc[it] = __builtin_amdgcn_mfma_f32_16x16x32_bf16(afr, bfr, acc[it], 0, 0, 0); }
            }
#pragma unroll
            for (int it = 0; it < 4; ++it) { const f32x4 v = acc[it];
                *(u32x2*)(WSP(bf16_t, WS_WOUT + l * WOUT_BYTES) + (size_t)(n0 + 16 * nt + lr) * D + i0 + 64 * ih + 16 * it + 4 * lq) = (u32x2){pk2(v.x, v.y), pk2(v.z, v.w)}; }
        }
        __syncthreads();
    }
}

template <int MODE>
__device__ __forceinline__ void norm_pass(const Args& a, int bid, int G) {
    const int tid = opaque(TIDX(a)), lane = tid & 63, wave = __builtin_amdgcn_readfirstlane(tid >> 6);
    const int gw = bid * 8 + wave, NGW = G * 8;
    const int nrows = (MODE == 2) ? TX : TT;
    const int rpw = (nrows + NGW - 1) / NGW;
    const int r0 = gw * rpw, r1 = (r0 + rpw < nrows) ? r0 + rpw : nrows;
    if (r0 >= r1) return;
    const float* modb = WSP(float, WS_MOD);
    f32x4 ca[4][2], cb[4][2], cg[4][2];
    int cur_mr = -1;
    f32x4 xn[4][2]; u32x4 xnb[4]; int sln = -1;
    auto load_row = [&](int row) {
        if (MODE == 0) { const float* src = (row < TX ? a.in[I_X] + (size_t)row * D : a.in[I_CTX] + (size_t)(row - TX) * D);
#pragma unroll
            for (int j = 0; j < 4; ++j)
#pragma unroll
                for (int h = 0; h < 2; ++h) xn[j][h] = *(const f32x4*)(src + 8 * lane + 512 * j + 4 * h); }
        else { const bf16_t* src = WSP(bf16_t, WS_XCUR) + (size_t)row * D;
#pragma unroll
            for (int j = 0; j < 4; ++j) xnb[j] = *(const u32x4*)(src + 8 * lane + 512 * j);
            sln = WSP(int, WS_SLOT)[(size_t)row * 16 + (lane & 15)]; } };
    load_row(r0);
    u32x4 yp[2][4]; int pe0 = -1, pe1 = -1;
    auto issue_yp = [&](int slots) {
        unsigned long long m2 = __builtin_amdgcn_ballot_w64(slots >= 0) & 0xFFFFull; pe0 = -1; pe1 = -1;
        if (m2) { pe0 = __builtin_ctzll(m2); m2 &= m2 - 1; const bf16_t* yr = WSP(bf16_t, WS_Y) + ((size_t)pe0 * ROWS_E + __builtin_amdgcn_readlane(slots, pe0)) * D;
#pragma unroll
            for (int j = 0; j < 4; ++j) yp[0][j] = *(const u32x4*)(yr + 8 * lane + 512 * j); }
        if (m2) { pe1 = __builtin_ctzll(m2); const bf16_t* yr = WSP(bf16_t, WS_Y) + ((size_t)pe1 * ROWS_E + __builtin_amdgcn_readlane(slots, pe1)) * D;
#pragma unroll
            for (int j = 0; j < 4; ++j) yp[1][j] = *(const u32x4*)(yr + 8 * lane + 512 * j); } };
    if (MODE >= 1) issue_yp(sln);
    for (int row = r0; row < r1; ++row) {
        f32x4 x[4][2]; const int slv = sln; const int ce0 = pe0, ce1 = pe1;
#pragma unroll
        for (int j = 0; j < 4; ++j) {
            if (MODE == 0) { x[j][0] = xn[j][0]; x[j][1] = xn[j][1]; }
            else { const u32x4 w = xnb[j]; x[j][0] = (f32x4){bflo(w.x), bfhi(w.x), bflo(w.y), bfhi(w.y)}; x[j][1] = (f32x4){bflo(w.z), bfhi(w.z), bflo(w.w), bfhi(w.w)}; } }
        if (row + 1 < r1) load_row(row + 1);
        const int mr = mrow_of(row);
        if (mr != cur_mr) { cur_mr = mr;
#pragma unroll
            for (int j = 0; j < 4; ++j)
#pragma unroll
                for (int h = 0; h < 2; ++h) { const int d = 8 * lane + 512 * j + 4 * h;
                    if (MODE == 2) { ca[j][h] = *(const f32x4*)(a.in[I_NFIN] + d); cb[j][h] = (f32x4){0.f, 0.f, 0.f, 0.f}; }
                    else { const int l = MODE; const f32x4 g = *(const f32x4*)(a.in[I_NMIX] + l * D + d); const f32x4 sc = *(const f32x4*)(modb + (size_t)(l * 9 + mr) * MODW + D + d);
                        ca[j][h] = g * (1.0f + sc); cb[j][h] = *(const f32x4*)(modb + (size_t)(l * 9 + mr) * MODW + d); }
                    if (MODE >= 1) cg[j][h] = *(const f32x4*)(modb + (size_t)((MODE - 1) * 9 + mr) * MODW + 5 * D + d); } }
        if (MODE >= 1) {
#pragma unroll
            for (int q = 0; q < 2; ++q) if ((q ? ce1 : ce0) >= 0) {
#pragma unroll
                for (int j = 0; j < 4; ++j) { const u32x4 w = yp[q][j];
                    x[j][0] += cg[j][0] * (f32x4){bflo(w.x), bfhi(w.x), bflo(w.y), bfhi(w.y)}; x[j][1] += cg[j][1] * (f32x4){bflo(w.z), bfhi(w.z), bflo(w.w), bfhi(w.w)}; } }
            unsigned long long msk = __builtin_amdgcn_ballot_w64(slv >= 0) & 0xFFFFull;
            if (msk) msk &= msk - 1;
            if (msk) msk &= msk - 1;
            while (msk) {
                const int e = __builtin_ctzll(msk); msk &= msk - 1; const int sr = __builtin_amdgcn_readlane(slv, e);
                const bf16_t* yr = WSP(bf16_t, WS_Y) + ((size_t)e * ROWS_E + sr) * D;
                u32x4 yv[4];
#pragma unroll
                for (int j = 0; j < 4; ++j) yv[j] = *(const u32x4*)(yr + 8 * lane + 512 * j);
#pragma unroll
                for (int j = 0; j < 4; ++j) { const u32x4 w = yv[j];
                    x[j][0] += cg[j][0] * (f32x4){bflo(w.x), bfhi(w.x), bflo(w.y), bfhi(w.y)}; x[j][1] += cg[j][1] * (f32x4){bflo(w.z), bfhi(w.z), bflo(w.w), bfhi(w.w)}; }
            }
            if (row + 1 < r1) issue_yp(sln);
            if (MODE == 1) {
                bf16_t* dstx = WSP(bf16_t, WS_XCUR) + (size_t)row * D;
#pragma unroll
                for (int j = 0; j < 4; ++j) *(u32x4*)(dstx + 8 * lane + 512 * j) = (u32x4){pk2(x[j][0].x, x[j][0].y), pk2(x[j][0].z, x[j][0].w), pk2(x[j][1].x, x[j][1].y), pk2(x[j][1].z, x[j][1].w)};
            }
        }
        float ss = 0.f;
#pragma unroll
        for (int j = 0; j < 4; ++j)
#pragma unroll
            for (int h = 0; h < 2; ++h) ss += (x[j][h].x * x[j][h].x + x[j][h].y * x[j][h].y) + (x[j][h].z * x[j][h].z + x[j][h].w * x[j][h].w);
        const float rstd = 1.0f / sqrtf(wave_sum(ss, lane) * (1.0f / D) + EPS);
        if (MODE == 2) {
            float* o = a.out + (size_t)row * D;
#pragma unroll
            for (int j = 0; j < 4; ++j)
#pragma unroll
                for (int h = 0; h < 2; ++h) *(f32x4*)(o + 8 * lane + 512 * j + 4 * h) = x[j][h] * rstd * ca[j][h];
        } else {
            bf16_t* o = WSP(bf16_t, WS_XM) + (size_t)row * D;
#pragma unroll
            for (int j = 0; j < 4; ++j) { const f32x4 v0 = x[j][0] * rstd * ca[j][0] + cb[j][0], v1 = x[j][1] * rstd * ca[j][1] + cb[j][1];
                *(u32x4*)(o + 8 * lane + 512 * j) = (u32x4){pk2(v0.x, v0.y), pk2(v0.z, v0.w), pk2(v1.x, v1.y), pk2(v1.z, v1.w)}; }
        }
    }
}

__device__ __forceinline__ void n2_pass(const Args& a, LAS unsigned char* lds, int l, int bid, int G) {
    const int tid = opaque(TIDX(a)), lane = tid & 63, wave = __builtin_amdgcn_readfirstlane(tid >> 6);
    LAS float* wrT = (LAS float*)lds;
    const float* wr = a.in[I_WR] + (size_t)l * D * NE;
    for (int d = tid; d < D; d += 512) {
        const f32x4 r0 = *(const f32x4*)(wr + d * 16), r1 = *(const f32x4*)(wr + d * 16 + 4), r2 = *(const f32x4*)(wr + d * 16 + 8), r3 = *(const f32x4*)(wr + d * 16 + 12);
        const float rv[16] = {r0.x, r0.y, r0.z, r0.w, r1.x, r1.y, r1.z, r1.w, r2.x, r2.y, r2.z, r2.w, r3.x, r3.y, r3.z, r3.w};
#pragma unroll
        for (int e = 0; e < 16; ++e) wrT[e * D + d] = rv[e]; }
    __syncthreads();
    const int npairs = ((l == 0) ? TT : TX) / 2;
    const int gw = bid * 8 + wave, NGW = G * 8;
    const int ppw = (npairs + NGW - 1) / NGW;
    const int p0 = gw * ppw, p1 = (p0 + ppw < npairs) ? p0 + ppw : npairs;
    const float* modb = WSP(float, WS_MOD);
    const bool b5 = (lane & 32) != 0, b4 = (lane & 16) != 0, b3 = (lane & 8) != 0, b2 = (lane & 4) != 0, b1 = (lane & 2) != 0;
    f32x4 ca[4][2], cb[4][2]; int cur_mr = -1;
    u32x4 xn[2][4];
    if (p0 < p1) {
#pragma unroll
        for (int r = 0; r < 2; ++r) { const bf16_t* src = WSP(bf16_t, WS_XCUR) + (size_t)(2 * p0 + r) * D;
#pragma unroll
            for (int j = 0; j < 4; ++j) xn[r][j] = *(const u32x4*)(src + 8 * lane + 512 * j); } }
    for (int p = p0; p < p1; ++p) {
        const int row0 = 2 * p, mr = mrow_of(row0);
        f32x4 xv[2][4][2];
#pragma unroll
        for (int r = 0; r < 2; ++r)
#pragma unroll
            for (int j = 0; j < 4; ++j) { const u32x4 w = xn[r][j]; xv[r][j][0] = (f32x4){bflo(w.x), bfhi(w.x), bflo(w.y), bfhi(w.y)}; xv[r][j][1] = (f32x4){bflo(w.z), bfhi(w.z), bflo(w.w), bfhi(w.w)}; }
        if (p + 1 < p1) {
#pragma unroll
            for (int r = 0; r < 2; ++r) { const bf16_t* src = WSP(bf16_t, WS_XCUR) + (size_t)(row0 + 2 + r) * D;
#pragma unroll
                for (int j = 0; j < 4; ++j) xn[r][j] = *(const u32x4*)(src + 8 * lane + 512 * j); } }
        if (mr != cur_mr) { cur_mr = mr;
#pragma unroll
            for (int j = 0; j < 4; ++j)
#pragma unroll
                for (int h = 0; h < 2; ++h) { const int d = 8 * lane + 512 * j + 4 * h;
                    const f32x4 g = *(const f32x4*)(a.in[I_NFFN] + l * D + d); const f32x4 sc = *(const f32x4*)(modb + (size_t)(l * 9 + mr) * MODW + 4 * D + d);
                    ca[j][h] = g * (1.0f + sc); cb[j][h] = *(const f32x4*)(modb + (size_t)(l * 9 + mr) * MODW + 3 * D + d); } }
#pragma unroll
        for (int r = 0; r < 2; ++r) {
            float ss = 0.f;
#pragma unroll
            for (int j = 0; j < 4; ++j)
#pragma unroll
                for (int h = 0; h < 2; ++h) { const f32x4 x = xv[r][j][h]; ss += (x.x * x.x + x.y * x.y) + (x.z * x.z + x.w * x.w); }
            const float rstd = 1.0f / sqrtf(wave_sum(ss, lane) * (1.0f / D) + EPS);
            bf16_t* o = WSP(bf16_t, WS_XM) + (size_t)(row0 + r) * D;
#pragma unroll
            for (int j = 0; j < 4; ++j) {
#pragma unroll
                for (int h = 0; h < 2; ++h) xv[r][j][h] = xv[r][j][h] * rstd * ca[j][h] + cb[j][h];
                const f32x4 v0 = xv[r][j][0], v1 = xv[r][j][1];
                *(u32x4*)(o + 8 * lane + 512 * j) = (u32x4){pk2(v0.x, v0.y), pk2(v0.z, v0.w), pk2(v1.x, v1.y), pk2(v1.z, v1.w)}; }
        }
        float v32[32];
#pragma unroll
        for (int e = 0; e < 16; ++e) { f32x2 a0 = {0.f, 0.f}, a1 = {0.f, 0.f};
#pragma unroll
            for (int j = 0; j < 4; ++j)
#pragma unroll
                for (int h = 0; h < 2; ++h) { const f32x4 w = *(const LAS f32x4*)(wrT + e * D + 8 * lane + 512 * j + 4 * h);
                    const f32x2 wl = {w.x, w.y}, wh = {w.z, w.w};
                    a0 += (f32x2){xv[0][j][h].x, xv[0][j][h].y} * wl; a0 += (f32x2){xv[0][j][h].z, xv[0][j][h].w} * wh;
                    a1 += (f32x2){xv[1][j][h].x, xv[1][j][h].y} * wl; a1 += (f32x2){xv[1][j][h].z, xv[1][j][h].w} * wh; }
            v32[e] = a0.x + a0.y; v32[16 + e] = a1.x + a1.y; asm volatile("" ::: "memory"); }
        float v16[16], v8[8], v4[4], v2[2];
#pragma unroll
        for (int i = 0; i < 16; ++i) { const float mine = b5 ? v32[16 + i] : v32[i], send = b5 ? v32[i] : v32[16 + i]; v16[i] = mine + shx(send, 32, lane); }
#pragma unroll
        for (int i = 0; i < 8; ++i) { const float mine = b4 ? v16[8 + i] : v16[i], send = b4 ? v16[i] : v16[8 + i]; v8[i] = mine + shx(send, 16, lane); }
#pragma unroll
        for (int i = 0; i < 4; ++i) { const float mine = b3 ? v8[4 + i] : v8[i], send = b3 ? v8[i] : v8[4 + i]; v4[i] = mine + shx(send, 8, lane); }
#pragma unroll
        for (int i = 0; i < 2; ++i) { const float mine = b2 ? v4[2 + i] : v4[i], send = b2 ? v4[i] : v4[2 + i]; v2[i] = mine + shx(send, 4, lane); }
        float lgv;
        { const float mine = b1 ? v2[1] : v2[0], send = b1 ? v2[0] : v2[1]; lgv = mine + shx(send, 2, lane); }
        lgv += shx(lgv, 1, lane);
        float mx = lgv;
        mx = fmaxf(mx, shx(mx, 2, lane)); mx = fmaxf(mx, shx(mx, 4, lane)); mx = fmaxf(mx, shx(mx, 8, lane)); mx = fmaxf(mx, shx(mx, 16, lane));
        const float pe = __expf(lgv - mx); float den = pe;
        den += shx(den, 2, lane); den += shx(den, 4, lane); den += shx(den, 8, lane); den += shx(den, 16, lane);
        if ((lane & 1) == 0) { const int ln = opaque(lane); const int row = row0 + (ln >> 5), e = (ln >> 1) & 15; float* dst;
            if (row < TX) dst = WSP(float, WS_AFF) + ((size_t)(row >> 11) * 16 + e) * LX + (row & (LX - 1));
            else { const int rc = row - TX; dst = WSP(float, WS_AFF) + (size_t)NB * 16 * LX + ((size_t)(rc >> 8) * 16 + e) * LC + (rc & (LC - 1)); }
            *dst = pe / den; }
    }
    __syncthreads();
}

__device__ __forceinline__ void topk_pass(const Args& a, LAS unsigned char* lds, int l, int bid, int G) {
    const int tid = opaque(TIDX(a));
    LAS unsigned long long* key = (LAS unsigned long long*)lds;
    const int nunits = (l == 0) ? 256 : 128;
    for (int u = bid; u < nunits; u += G) {
        const bool isx = u < 128; const int b = (u & 127) >> 4, e = u & 15; const int L = isx ? LX : LC, cap = isx ? CAPX : CAPC;
        const float* src = isx ? WSP(float, WS_AFF) + ((size_t)b * 16 + e) * LX : WSP(float, WS_AFF) + (size_t)NB * 16 * LX + ((size_t)b * 16 + e) * LC;
        __syncthreads();
        for (int i = tid; i < L; i += 512) key[i] = ((unsigned long long)__builtin_bit_cast(unsigned, src[i]) << 32) | (unsigned long long)(0xFFFFFFFFu - (unsigned)i);
        const int lane_ = tid & 63, wave_ = __builtin_amdgcn_readfirstlane(tid >> 6);
        __syncthreads();
        for (int k = 2; k <= L; k <<= 1) {
            int j = k >> 1;
            for (; j >= 256; j >>= 1) {
                __syncthreads();
                for (int i = tid; i < L / 2; i += 512) {
                    const int idx = 2 * i - (i & (j - 1)), ixj = idx | j;
                    const unsigned long long x = key[idx], y = key[ixj];
                    const bool desc = (idx & k) == 0;
                    if ((x < y) == desc) { key[idx] = y; key[ixj] = x; }
                }
                if (j == 256) __syncthreads();
            }
            if (256 * wave_ < L) {
                for (; j > 0; j >>= 1) {
#pragma unroll
                    for (int q = 0; q < 2; ++q) { const int i = 128 * wave_ + lane_ + 64 * q;
                        const int idx = 2 * i - (i & (j - 1)), ixj = idx | j;
                        const unsigned long long x = key[idx], y = key[ixj];
                        const bool desc = (idx & k) == 0;
                        if ((x < y) == desc) { key[idx] = y; key[ixj] = x; } }
                    asm volatile("s_waitcnt lgkmcnt(0)" ::: "memory");
                }
            }
        }
        __syncthreads();
        for (int p = tid; p < L; p += 512) {
            const unsigned long long kv = key[p]; const int t = (int)(0xFFFFFFFFu - (unsigned)kv);
            const int row = isx ? b * LX + t : TX + b * LC + t;
            int slot = -1;
            if (p < cap) { slot = isx ? b * CAPX + p : NB * CAPX + b * CAPC + p;
                WSP(int, WS_IDX)[e * ROWS_E + slot] = row; WSP(float, WS_GATE)[e * ROWS_E + slot] = __builtin_bit_cast(float, (unsigned)(kv >> 32)); }
            WSP(int, WS_SLOT)[(size_t)row * 16 + e] = slot;
        }
    }
    __syncthreads();
}

__device__ __forceinline__ void gather_pass(const Args& a, int l, int bid, int G) {
    const int tid = opaque(TIDX(a)), lane = tid & 63, wave = __builtin_amdgcn_readfirstlane(tid >> 6);
    const int gw = bid * 8 + wave, NGW = G * 8; const int rows_e = (l == 0) ? ROWS_E : NB * CAPX;
    for (int it = gw; it < NE * rows_e; it += NGW) { const int e = it / rows_e, s = it % rows_e;
        const int row = WSP(int, WS_IDX)[e * ROWS_E + s];
        const u32x4* src = (const u32x4*)(WSP(bf16_t, WS_XM) + (size_t)row * D); u32x4* dst = (u32x4*)(WSP(bf16_t, WS_XS) + ((size_t)e * ROWS_E + s) * D);
#pragma unroll
        for (int j = 0; j < 4; ++j) dst[lane + 64 * j] = src[lane + 64 * j]; }
}

__device__ __forceinline__ void hgrn_out_pass(const Args& a, LAS unsigned char* lds, int l, int bid, int G) {
    const int tid = opaque(TIDX(a)), lane = tid & 63, wave = __builtin_amdgcn_readfirstlane(tid >> 6);
    const int gw = bid * 8 + wave, NGW = G * 8; const int nrows = (l == 0) ? TT : TX;
    {
        constexpr int TP = 132;
        LAS unsigned char* tile = lds + wave * (64 * TP);
        const int njobs = (l == 0) ? 2048 + 256 : 2048;
        for (int j = gw; j < njobs; j += NGW) {
            const bool isx = j < 2048; const int jj = isx ? j : j - 2048; const int L = isx ? LX : LC;
            const int tb = isx ? (jj & 31) : (jj & 3), cg = isx ? ((jj >> 5) & 7) : ((jj >> 2) & 7), b = isx ? (jj >> 8) : (jj >> 5);
            const bf16_t* src = (isx ? WSP(bf16_t, WS_HTX) : WSP(bf16_t, WS_HTC)) + ((size_t)b * 1536 + cg * 64) * L + tb * 64;
            u32x4 v[8];
#pragma unroll
            for (int i = 0; i < 8; ++i) v[i] = *(const u32x4*)(src + (size_t)((lane >> 3) + 8 * i) * L + (lane & 7) * 8);
#pragma unroll
            for (int i = 0; i < 8; ++i) { const int c = (lane >> 3) + 8 * i; LAS unsigned char* w = tile + ((lane & 7) * 8) * TP + c * 2; const unsigned ww[4] = {v[i].x, v[i].y, v[i].z, v[i].w};
#pragma unroll
                for (int k = 0; k < 4; ++k) { *(LAS unsigned short*)(w + (2 * k) * TP) = (unsigned short)(ww[k] & 0xffffu); *(LAS unsigned short*)(w + (2 * k + 1) * TP) = (unsigned short)(ww[k] >> 16); } }
            asm volatile("" ::: "memory");
            bf16_t* dst = WSP(bf16_t, WS_MIX) + (size_t)((isx ? b * LX : TX + b * LC) + tb * 64) * D + 512 + cg * 64;
#pragma unroll
            for (int i = 0; i < 8; ++i) { const int t = (lane >> 3) + 8 * i; const LAS unsigned* r = (const LAS unsigned*)(tile + t * TP + (lane & 7) * 16);
                *(u32x4*)(dst + (size_t)t * D + (lane & 7) * 8) = (u32x4){r[0], r[1], r[2], r[3]}; }
            asm volatile("" ::: "memory");
        }
    }
    float gn[16];
#pragma unroll
    for (int k = 0; k < 16; ++k) gn[k] = a.in[I_HGNG][l * 1024 + 16 * lane + k];
    u32x4 nf[2], nb[2], ng[2];
    auto load_row = [&](int row) { const u32x4* pf = (const u32x4*)(WSP(bf16_t, WS_OF) + (size_t)row * 1024 + 16 * lane); const u32x4* pb = (const u32x4*)(WSP(bf16_t, WS_OB) + (size_t)row * 1024 + 16 * lane);
        const u32x4* pg = (const u32x4*)(WSP(bf16_t, WS_HG) + (size_t)row * HGW + 4096 + 16 * lane);
        nf[0] = pf[0]; nf[1] = pf[1]; nb[0] = pb[0]; nb[1] = pb[1]; ng[0] = pg[0]; ng[1] = pg[1]; };
    if (gw < nrows) load_row(gw);
    for (int row = gw; row < nrows; row += NGW) {
        float o[16], g[16]; float ss = 0.f;
#pragma unroll
        for (int q = 0; q < 2; ++q) { const u32x4 f = nf[q], bb = nb[q], gg = ng[q]; const unsigned fw[4] = {f.x, f.y, f.z, f.w}, bw[4] = {bb.x, bb.y, bb.z, bb.w}, gw4[4] = {gg.x, gg.y, gg.z, gg.w};
#pragma unroll
            for (int k = 0; k < 4; ++k) { o[8 * q + 2 * k] = bflo(fw[k]) + bflo(bw[k]); o[8 * q + 2 * k + 1] = bfhi(fw[k]) + bfhi(bw[k]); g[8 * q + 2 * k] = bflo(gw4[k]); g[8 * q + 2 * k + 1] = bfhi(gw4[k]); } }
        if (row + NGW < nrows) load_row(row + NGW);
#pragma unroll
        for (int k = 0; k < 16; ++k) ss += o[k] * o[k];
        ss += shx(ss, 1, lane); ss += shx(ss, 2, lane); ss += shx(ss, 4, lane);
        const float rstd = 1.0f / sqrtf(ss * (1.0f / 128.0f) + EPS);
        unsigned w[8];
#pragma unroll
        for (int k = 0; k < 8; ++k) { const float y0 = o[2 * k] * rstd * gn[2 * k] * (g[2 * k] * sigmoidf_(g[2 * k])), y1 = o[2 * k + 1] * rstd * gn[2 * k + 1] * (g[2 * k + 1] * sigmoidf_(g[2 * k + 1])); w[k] = pk2(y0, y1); }
        u32x4* dst = (u32x4*)(WSP(bf16_t, WS_MIX) + (size_t)row * D + 1024 + 16 * lane);
        dst[0] = (u32x4){w[0], w[1], w[2], w[3]}; dst[1] = (u32x4){w[4], w[5], w[6], w[7]};
    }
}

typedef f32x4 AccT[2][2][4][2];
using pg8::EPI_RS;
__device__ __forceinline__ void epi_rows64(LAS unsigned char* scr, int fr, int fq, const u32x2 (&p)[2][2], char* g, unsigned ld) {
    LAS unsigned char* w = scr + fr * EPI_RS + 8 * fq;
#pragma unroll
    for (int bj = 0; bj < 2; ++bj)
#pragma unroll
        for (int n = 0; n < 2; ++n) *(LAS u32x2*)(w + 64 * bj + 32 * n) = p[bj][n];
    const int lane = fq * 16 + fr, rr = lane >> 3, pc = (lane & 7) * 16;
    const u32x4 q0 = *(const LAS u32x4*)(scr + rr * EPI_RS + pc), q1 = *(const LAS u32x4*)(scr + (rr + 8) * EPI_RS + pc);
    *(u32x4*)(g + rr * ld + pc) = q0; *(u32x4*)(g + (rr + 8) * ld + pc) = q1;
}
__device__ __forceinline__ void epi_rows32(LAS unsigned char* scr, int fr, int fq, const u32x2 (&p)[2], char* g, unsigned ld) {
    LAS unsigned char* w = scr + fr * 80 + 8 * fq;
    *(LAS u32x2*)(w) = p[0]; *(LAS u32x2*)(w + 32) = p[1];
    const int lane = fq * 16 + fr, rr = lane >> 2, pc = (lane & 3) * 16;
    const u32x4 q0 = *(const LAS u32x4*)(scr + rr * 80 + pc);
    *(u32x4*)(g + rr * ld + pc) = q0;
}
__device__ __forceinline__ void epi_cols16(LAS unsigned char* scr, int fr, int fq, const f32x4 (&v)[4], char* g, unsigned off0, unsigned off1) {
    const bool odd = fr & 1;
    LAS unsigned char* w = scr + (4 * fq + (odd ? 2 : 0)) * EPI_RS + (fr >> 1) * 4;
#pragma unroll
    for (int m = 0; m < 4; ++m) {
        const float s0 = odd ? v[m].x : v[m].z, s1 = odd ? v[m].y : v[m].w;
        const float r0 = __builtin_bit_cast(float, __builtin_amdgcn_update_dpp(0, __builtin_bit_cast(int, s0), 0xB1, 0xF, 0xF, true));
        const float r1 = __builtin_bit_cast(float, __builtin_amdgcn_update_dpp(0, __builtin_bit_cast(int, s1), 0xB1, 0xF, 0xF, true));
        const unsigned w0 = odd ? pk2(r0, v[m].z) : pk2(v[m].x, r0), w1 = odd ? pk2(r1, v[m].w) : pk2(v[m].y, r1);
        *(LAS unsigned*)(w + m * 32) = w0; *(LAS unsigned*)(w + EPI_RS + m * 32) = w1;
    }
    const int lane = fq * 16 + fr, cc = lane >> 3, pc = (lane & 7) * 16;
    const u32x4 q0 = *(const LAS u32x4*)(scr + cc * EPI_RS + pc), q1 = *(const LAS u32x4*)(scr + (cc + 8) * EPI_RS + pc);
    *(u32x4*)(g + off0) = q0; *(u32x4*)(g + off1) = q1;
}
template <class Map> struct StrideOrder {
    Map map; int NU, G, c;
    __device__ __forceinline__ bool next(int i, Unit& u) const { const long L = (long)i * G + c; if (L >= NU) return false; map((int)L, u); return true; }
};

struct MapG1 { const bf16_t* A; const bf16_t* B; int nM; int nfull;
    __device__ __forceinline__ void operator()(int L, Unit& u) const { int pm, pn;
        if (L < nfull) pg8::tile_of(L, nM, NIN / 256, pm, pn); else { const int r = L - nfull; pm = TX / 256 + (r & 7); pn = 12 + (r >> 3); }
        u.pm = pm; u.pn = pn; u.aux = 0;
        u.A = (const char*)(A + (size_t)pm * 256 * D); u.B = (const char*)(B + (size_t)pn * 256 * D); } };
struct EpiG1 { static constexpr bool IDEM = true; bf16_t *FTX, *FTC, *HTX, *HTC, *HG;
    __device__ __forceinline__ void operator()(const AccT& acc, const Unit& u, int wr, int wc, int fr, int fq, LAS unsigned char* scr) const {
        const int row0 = u.pm * 256, col0 = u.pn * 256; const bool isx = row0 < TX;
        const int b = isx ? (row0 >> 11) : ((row0 - TX) >> 8), t0 = isx ? (row0 & (LX - 1)) : 0, L = isx ? LX : LC;
        if (col0 >= 2048) {
            char* base = (char*)(HG + (size_t)(row0 + wr * 64) * HGW + (col0 - 2048) + wc * 64);
#pragma unroll
            for (int ai = 0; ai < 2; ++ai)
#pragma unroll
                for (int m = 0; m < 4; ++m) { u32x2 p[2][2];
#pragma unroll
                    for (int bj = 0; bj < 2; ++bj)
#pragma unroll
                        for (int n = 0; n < 2; ++n) { const f32x4 v = acc[ai][bj][m][n]; p[bj][n] = (u32x2){pk2(v.x, v.y), pk2(v.z, v.w)}; }
                    epi_rows64(scr, fr, fq, p, base + (size_t)(ai * 128 + m * 16) * (HGW * 2), HGW * 2); }
        } else {
            const bool fou = col0 < 512; const int lane = fq * 16 + fr, cc = lane >> 3, pc = (lane & 7) * 16;
            bf16_t* base; size_t ldc;
            if (fou) { ldc = 2 * L; base = (isx ? FTX + (size_t)b * 512 * 4096 : FTC + (size_t)b * 512 * 512) + t0 + wr * 64; }
            else { ldc = L; base = (isx ? HTX + (size_t)b * 1536 * LX : HTC + (size_t)b * 1536 * LC) + (size_t)(col0 - 512) * ldc + t0 + wr * 64; }
#pragma unroll
            for (int ai = 0; ai < 2; ++ai)
#pragma unroll
                for (int bj = 0; bj < 2; ++bj)
#pragma unroll
                    for (int n = 0; n < 2; ++n) { const f32x4 v[4] = {acc[ai][bj][0][n], acc[ai][bj][1][n], acc[ai][bj][2][n], acc[ai][bj][3][n]};
                        const int cb = wc * 64 + bj * 32 + n * 16 + cc;
                        unsigned off[2];
#pragma unroll
                        for (int h2 = 0; h2 < 2; ++h2) { const int c = cb + 8 * h2;
                            if (fou) { const int fc = col0 + c, j = fc & 127; off[h2] = (unsigned)((((fc & ~127) + (j <= 64 ? j : j - 64)) * (2 * L) + (j > 64 ? L : 0)) * 2 + pc); }
                            else off[h2] = (unsigned)(c * (int)ldc * 2 + pc); }
                        epi_cols16(scr, fr, fq, v, (char*)(base + ai * 128), off[0], off[1]); }
        }
    } };

struct MapDftX { const bf16_t* A; const bf16_t* FT;
    __device__ __forceinline__ void operator()(int L, Unit& u) const { const int b = L >> 4, pm = (L >> 1) & 7, pn = L & 1; u.pm = pm; u.pn = pn; u.aux = b * LX;
        u.A = (const char*)(A + (size_t)pm * 256 * LX); u.B = (const char*)(FT + ((size_t)b * 512 + pn * 256) * 4096); } };
struct MapDftC { const bf16_t* A; const bf16_t* FT;
    __device__ __forceinline__ void operator()(int L, Unit& u) const { const int b = L >> 1, pn = L & 1; u.pm = 0; u.pn = pn; u.aux = TX + b * LC;
        u.A = (const char*)A; u.B = (const char*)(FT + ((size_t)b * 512 + pn * 256) * 512); } };
struct OneUnit { Unit u0;
    __device__ __forceinline__ bool next(int i, Unit& u) const { if (i != 0) return false; u = u0; return true; } };
struct EpiDft { static constexpr bool IDEM = true; bf16_t* mix;
    __device__ __forceinline__ void operator()(const AccT& acc, const Unit& u, int wr, int wc, int fr, int fq, LAS unsigned char* scr) const {
        char* base = (char*)(mix + (size_t)(u.aux + u.pm * 256 + wr * 64) * D + u.pn * 256 + wc * 64);
#pragma unroll
        for (int ai = 0; ai < 2; ++ai)
#pragma unroll
            for (int m = 0; m < 4; ++m) { u32x2 p[2][2];
#pragma unroll
                for (int bj = 0; bj < 2; ++bj)
#pragma unroll
                    for (int n = 0; n < 2; ++n) { const f32x4 v = acc[ai][bj][m][n]; p[bj][n] = (u32x2){pk2(v.x, v.y), pk2(v.z, v.w)}; }
                epi_rows64(scr, fr, fq, p, base + (size_t)(ai * 128 + m * 16) * (D * 2), D * 2); }
    } };

struct MapG2 { const bf16_t* A; const bf16_t* B; int nM;
    __device__ __forceinline__ void operator()(int L, Unit& u) const { int pm, pn; pg8::tile_of(L, nM, D / 256, pm, pn); u.pm = pm; u.pn = pn; u.aux = 0;
        u.A = (const char*)(A + (size_t)pm * 256 * D); u.B = (const char*)(B + (size_t)pn * 256 * D); } };
struct EpiG2 { static constexpr bool IDEM = false; const float* xin; const float* cin; bf16_t* xcur; const float* modl; int l;
    __device__ __forceinline__ void operator()(const AccT& acc, const Unit& u, int wr, int wc, int fr, int fq, LAS unsigned char* scr) const {
        const int row0 = u.pm * 256, mr = mrow_of(row0); const int colw = u.pn * 256 + wc * 64, colb = colw + 4 * fq;
        const char* bsrc = (const char*)(row0 < TX ? xin + (size_t)row0 * D : cin + (size_t)(row0 - TX) * D);
        char* xrow = (char*)(xcur + (size_t)row0 * D);
        char* xw = xrow + ((size_t)(wr * 64) * D + colw) * 2;
        f32x4 g1[2][2];
#pragma unroll
        for (int bj = 0; bj < 2; ++bj)
#pragma unroll
            for (int n = 0; n < 2; ++n) g1[bj][n] = *(const f32x4*)(modl + (size_t)mr * MODW + 2 * D + colb + bj * 32 + n * 16);
        const int lane = fq * 16 + fr;
        if (l == 0) {
            const unsigned lo = (unsigned)((wr * 64 + (lane >> 4)) * D + colw + (lane & 15) * 4);
#pragma unroll
            for (int g2 = 0; g2 < 4; ++g2) { const int ai = g2 >> 1, m0 = (g2 & 1) * 2;
                f32x4 bs[2][4];
#pragma unroll
                for (int mm = 0; mm < 2; ++mm)
#pragma unroll
                    for (int i = 0; i < 4; ++i) bs[mm][i] = *(const f32x4*)(bsrc + (lo + (unsigned)((ai * 128 + (m0 + mm) * 16 + 4 * i) * D)) * 4u);
#pragma unroll
                for (int mm = 0; mm < 2; ++mm) {
#pragma unroll
                    for (int i = 0; i < 4; ++i) *(LAS u32x2*)(scr + ((lane >> 4) + 4 * i) * EPI_RS + (lane & 15) * 8) = (u32x2){pk2(bs[mm][i].x, bs[mm][i].y), pk2(bs[mm][i].z, bs[mm][i].w)};
                    u32x2 p[2][2];
#pragma unroll
                    for (int bj = 0; bj < 2; ++bj)
#pragma unroll
                        for (int n = 0; n < 2; ++n) { const u32x2 w = *(const LAS u32x2*)(scr + fr * EPI_RS + 64 * bj + 32 * n + 8 * fq);
                            const f32x4 v = (f32x4){bflo(w.x), bfhi(w.x), bflo(w.y), bfhi(w.y)} + g1[bj][n] * acc[ai][bj][m0 + mm][n]; p[bj][n] = (u32x2){pk2(v.x, v.y), pk2(v.z, v.w)}; }
                    epi_rows64(scr, fr, fq, p, xw + (size_t)(ai * 128 + (m0 + mm) * 16) * (D * 2), D * 2); }
            }
        } else {
            const unsigned lo = (unsigned)((lane >> 3) * D * 2 + (lane & 7) * 16);
#pragma unroll
            for (int ai = 0; ai < 2; ++ai) {
                u32x4 bw[4][2];
#pragma unroll
                for (int m = 0; m < 4; ++m)
#pragma unroll
                    for (int i = 0; i < 2; ++i) bw[m][i] = *(const u32x4*)(xw + (size_t)(ai * 128 + m * 16 + 8 * i) * (D * 2) + lo);
#pragma unroll
                for (int m = 0; m < 4; ++m) {
#pragma unroll
                    for (int i = 0; i < 2; ++i) *(LAS u32x4*)(scr + ((lane >> 3) + 8 * i) * EPI_RS + (lane & 7) * 16) = bw[m][i];
                    u32x2 p[2][2];
#pragma unroll
                    for (int bj = 0; bj < 2; ++bj)
#pragma unroll
                        for (int n = 0; n < 2; ++n) { const u32x2 w = *(const LAS u32x2*)(scr + fr * EPI_RS + 64 * bj + 32 * n + 8 * fq);
                            const f32x4 v = (f32x4){bflo(w.x), bfhi(w.x), bflo(w.y), bfhi(w.y)} + g1[bj][n] * acc[ai][bj][m][n]; p[bj][n] = (u32x2){pk2(v.x, v.y), pk2(v.z, v.w)}; }
                    epi_rows64(scr, fr, fq, p, xw + (size_t)(ai * 128 + m * 16) * (D * 2), D * 2); }
            }
        }
    } };

struct MapE1 { const bf16_t* XS; const bf16_t* W; int ntm;
    __device__ __forceinline__ void operator()(int L, Unit& u) const { const int per = ntm * 8, e = L / per, r = L % per; u.pm = r % ntm; u.pn = r / ntm; u.aux = e;
        u.A = (const char*)XS; u.B = (const char*)(W + ((size_t)e * 2 * FF + u.pn * 256) * D); } };
struct EpiE1 { static constexpr bool IDEM = true; bf16_t* hid;
    __device__ __forceinline__ void operator()(const AccT& acc, const Unit& u, int wr, int wc, int fr, int fq, LAS unsigned char* scr) const {
        char* base = (char*)(hid + (((size_t)u.aux * (ROWS_E / 256) + u.pm) * 8 + u.pn) * 32768 + (wr * 64) * 128 + wc * 32);
#pragma unroll
        for (int ai = 0; ai < 2; ++ai)
#pragma unroll
            for (int m = 0; m < 4; ++m) { u32x2 p[2];
#pragma unroll
                for (int n = 0; n < 2; ++n) { const f32x4 g = acc[ai][0][m][n], v = acc[ai][1][m][n];
                    const float h0 = g.x * sigmoidf_(g.x) * v.x, h1 = g.y * sigmoidf_(g.y) * v.y, h2 = g.z * sigmoidf_(g.z) * v.z, h3 = g.w * sigmoidf_(g.w) * v.w;
                    p[n] = (u32x2){pk2(h0, h1), pk2(h2, h3)}; }
                epi_rows32(scr, fr, fq, p, base + (size_t)(ai * 128 + m * 16) * 256, 256); }
    } };

struct MapE2 { const bf16_t* H; const bf16_t* W; int ntm;
    __device__ __forceinline__ void operator()(int L, Unit& u) const { const int per = ntm * 8, e = L / per, r = L % per; u.pm = r % ntm; u.pn = r / ntm; u.aux = e;
        u.A = (const char*)(H + (((size_t)e * (ROWS_E / 256) + u.pm) * 8) * 32768); u.B = (const char*)(W + ((size_t)e * D + u.pn * 256) * FF); } };
struct EpiE2 { static constexpr bool IDEM = true; bf16_t* Y; const float* gate;
    __device__ __forceinline__ void operator()(const AccT& acc, const Unit& u, int wr, int wc, int fr, int fq, LAS unsigned char* scr) const {
        const size_t rw = (size_t)u.aux * ROWS_E + u.pm * 256 + wr * 64, rb = rw + fr;
        char* base = (char*)(Y + rw * D + u.pn * 256 + wc * 64);
        float gts[2][4];
#pragma unroll
        for (int ai = 0; ai < 2; ++ai)
#pragma unroll
            for (int m = 0; m < 4; ++m) gts[ai][m] = gate[rb + ai * 128 + m * 16];
#pragma unroll
        for (int ai = 0; ai < 2; ++ai)
#pragma unroll
            for (int m = 0; m < 4; ++m) { const float gt = gts[ai][m]; u32x2 p[2][2];
#pragma unroll
                for (int bj = 0; bj < 2; ++bj)
#pragma unroll
                    for (int n = 0; n < 2; ++n) { const f32x4 v = acc[ai][bj][m][n] * gt; p[bj][n] = (u32x2){pk2(v.x, v.y), pk2(v.z, v.w)}; }
                epi_rows64(scr, fr, fq, p, base + (size_t)(ai * 128 + m * 16) * (D * 2), D * 2); }
    } };

constexpr int HQ_QP = 0, HQ_KV = 17408, HQ_KHT = 60928, HQ_VT = 79360, HQ_AM = 97792, HQ_ST = 107008, HQ_TOT = 141824, HQ_DV = 145920, HQ_END = 146432;
constexpr int RS_K = 272, RS_S = 144;
constexpr int HQ_QT = HQ_END;
static_assert(HQ_QT + 64 * 256 <= LDS_CTL, "hgrn LDS map");
#ifndef HG_REP
#define HG_REP 0
#endif
#define MFMA16(a_, b_, c_) __builtin_amdgcn_mfma_f32_16x16x32_bf16((a_), (b_), (c_), 0, 0, 0)
__device__ __forceinline__ void hgrn_seq(const Args& a, LAS unsigned char* lds, int l, int unit) {
    const int tid = opaque(TIDX(a)), lane = tid & 63, wave = __builtin_amdgcn_readfirstlane(tid >> 6);
    const int b = unit >> 4, h = (unit >> 1) & 7, dir = unit & 1;
    const int J = wave >> 1, hf = wave & 1;
    const int lr = lane & 15, lq = lane >> 4;
    const bf16_t* HG = WSP(bf16_t, WS_HG);
    bf16_t* OUT = dir ? WSP(bf16_t, WS_OB) : WSP(bf16_t, WS_OF);
    float lb[2] = {0.f, 0.f};
    if (l == 1) {
#pragma unroll
        for (int c = 0; c < 2; ++c) { const int ch = h * 128 + 2 * lane + c; const float a0 = a.in[I_HGLB][(0 * 2 + dir) * 1024 + ch], a1 = a.in[I_HGLB][(1 * 2 + dir) * 1024 + ch]; lb[c] = 1.0f / (1.0f + __expf(a0 - a1)); } }
    for (int i = tid; i < (HQ_TOT - HQ_AM) / 16; i += 512) *(LAS u32x4*)(lds + HQ_AM + i * 16) = (u32x4){0u, 0u, 0u, 0u};
    f32x4 S[2][4];
#pragma unroll
    for (int i = 0; i < 2; ++i)
#pragma unroll
        for (int j = 0; j < 4; ++j) S[i][j] = (f32x4){0.f, 0.f, 0.f, 0.f};
    const int kt0 = 2 * (wave >> 1), vt0 = 4 * (wave & 1);
    __syncthreads();
    const int colq = h * 128 + 2 * lane, colf = (1 + dir) * 1024 + colq, colv = 3 * 1024 + colq;
    unsigned pzq[8], pzf[8], pzv[8];
    {
#pragma unroll
        for (int m = 0; m < 8; ++m) { const int i = 8 * wave + m; const int t = dir ? (LC - 1 - i) : i; const bf16_t* p = HG + (size_t)(TX + b * LC + t) * HGW;
            pzq[m] = *(const unsigned*)(p + colq); pzf[m] = *(const unsigned*)(p + colf); pzv[m] = *(const unsigned*)(p + colv); }
    }
    u32x2 opk[4]; int oci = -1;
#pragma unroll
    for (int it = 0; it < 4; ++it) opk[it] = (u32x2){0u, 0u};
    auto flush_o = [&]() {
        if (oci >= 0) { const bool ox = oci >= 4; const int oL = ox ? LX : LC, orb = ox ? b * LX : TX + b * LC, ojc = ox ? oci - 4 : oci;
#pragma unroll
            for (int it = 0; it < 4; ++it) { const int i = 64 * ojc + 16 * it + lr; const int t = dir ? (oL - 1 - i) : i;
                *(u32x2*)(OUT + (size_t)(orb + t) * 1024 + h * 128 + 16 * wave + 4 * lq) = opk[it]; }
            oci = -1; } };
    for (int ci = 0; ci < 36; ++ci) {
        const bool isx = ci >= 4; const int L = isx ? LX : LC, rowbase = isx ? b * LX : TX + b * LC, jc = isx ? ci - 4 : ci;
        f32x2 q[8], P[8], e1[8], fv[8]; unsigned vv[8];
        {
            const f32x2 lb2 = {lb[0], lb[1]}, omlb = (f32x2){1.0f, 1.0f} - lb2;
            f32x2 run = {1.f, 1.f};
#pragma unroll
            for (int m = 0; m < 8; ++m) { const f32x2 zq = {bflo(pzq[m]), bfhi(pzq[m])}, zf = {bflo(pzf[m]), bfhi(pzf[m])};
                if (isx || l == 0) q[m] = zq * (f32x2){sigmoidf_(zq.x), sigmoidf_(zq.y)};
                const f32x2 f = __builtin_elementwise_max(lb2 + omlb * (f32x2){sigmoidf_(zf.x), sigmoidf_(zf.y)}, (f32x2){1e-6f, 1e-6f});
                fv[m] = f; run *= f; P[m] = run; }
            f32x2 suf = {1.f, 1.f};
#pragma unroll
            for (int m = 7; m >= 0; --m) { e1[m] = suf; suf *= fv[m]; }
            ((LAS float*)(lds + HQ_TOT))[(2 * lane) * 8 + wave] = P[7].x; ((LAS float*)(lds + HQ_TOT))[(2 * lane + 1) * 8 + wave] = P[7].y;
        }
#pragma unroll
        for (int m = 0; m < 8; ++m) vv[m] = pzv[m];
        __syncthreads();
        flush_o();
        f32x2 EJ, GS, pre, post, tt[4];
        {
            const f32x4 sa0 = *(const LAS f32x4*)(lds + HQ_TOT + (2 * lane) * 32), sb0 = *(const LAS f32x4*)(lds + HQ_TOT + (2 * lane) * 32 + 16);
            const f32x4 sa1 = *(const LAS f32x4*)(lds + HQ_TOT + (2 * lane + 1) * 32), sb1 = *(const LAS f32x4*)(lds + HQ_TOT + (2 * lane + 1) * 32 + 16);
            const f32x2 sg[8] = {{sa0.x, sa1.x}, {sa0.y, sa1.y}, {sa0.z, sa1.z}, {sa0.w, sa1.w}, {sb0.x, sb1.x}, {sb0.y, sb1.y}, {sb0.z, sb1.z}, {sb0.w, sb1.w}};
#pragma unroll
            for (int jj = 0; jj < 4; ++jj) tt[jj] = sg[2 * jj] * sg[2 * jj + 1];
            EJ = (f32x2){1.f, 1.f}; GS = EJ;
#pragma unroll
            for (int jj = 0; jj < 4; ++jj) { if (jj < J) EJ *= tt[jj]; if (jj > J) GS *= tt[jj]; }
            f32x2 first = sg[0], second = sg[1];
#pragma unroll
            for (int jj = 1; jj < 4; ++jj) { if (jj == J) { first = sg[2 * jj]; second = sg[2 * jj + 1]; } }
            pre = hf ? first : (f32x2){1.f, 1.f}; post = hf ? (f32x2){1.f, 1.f} : second;
        }
        const bool need_o = isx || l == 0;
        {
#pragma unroll
            for (int m = 0; m < 8; ++m) {
                const f32x2 Pf = P[m] * pre; P[m] = Pf;
                const f32x2 kkm = (f32x2){1.0f, 1.0f} - fv[m], ke = kkm * (e1[m] * post);
                if (need_o) {
                const f32x2 Qv = q[m] * Pf;
                const f32x2 Kd = kkm * __builtin_elementwise_min((f32x2){__builtin_amdgcn_rcpf(Pf.x), __builtin_amdgcn_rcpf(Pf.y)}, (f32x2){1e30f, 1e30f});
                const int row = 8 * wave + m, rs = 8 * hf + m;
                *(LAS unsigned*)(lds + HQ_QP + row * RS_K + 4 * lane) = pk2(Qv.x, Qv.y);
                { const f32x2 qt = Qv * EJ; *(LAS unsigned*)(lds + HQ_QT + row * 256 + (((lane >> 2) ^ (row & 15)) << 4) + (lane & 3) * 4) = pk2(qt.x, qt.y); }
                *(LAS unsigned*)(lds + HQ_KV + (16 * (J * (J + 1) / 2 + J) + rs) * RS_K + 4 * lane) = pk2(Kd.x, Kd.y);
                f32x2 Gm = {1.f, 1.f};
#pragma unroll
                for (int I = 1; I < 4; ++I) { if (I > J) { const f32x2 kv = ke * Gm; *(LAS unsigned*)(lds + HQ_KV + (16 * (I * (I + 1) / 2 + J) + rs) * RS_K + 4 * lane) = pk2(kv.x, kv.y); Gm *= tt[I]; } }
                }
                e1[m] = ke * GS;
            }
            *(LAS u32x4*)(lds + HQ_KHT + (2 * lane) * RS_S + 16 * wave) = (u32x4){pk2(e1[0].x, e1[1].x), pk2(e1[2].x, e1[3].x), pk2(e1[4].x, e1[5].x), pk2(e1[6].x, e1[7].x)};
            *(LAS u32x4*)(lds + HQ_KHT + (2 * lane + 1) * RS_S + 16 * wave) = (u32x4){pk2(e1[0].y, e1[1].y), pk2(e1[2].y, e1[3].y), pk2(e1[4].y, e1[5].y), pk2(e1[6].y, e1[7].y)};
            *(LAS u32x4*)(lds + HQ_VT + (2 * lane) * RS_S + 16 * wave) = (u32x4){(vv[0] & 0xffffu) | (vv[1] << 16), (vv[2] & 0xffffu) | (vv[3] << 16), (vv[4] & 0xffffu) | (vv[5] << 16), (vv[6] & 0xffffu) | (vv[7] << 16)};
            *(LAS u32x4*)(lds + HQ_VT + (2 * lane + 1) * RS_S + 16 * wave) = (u32x4){(vv[0] >> 16) | (vv[1] & 0xffff0000u), (vv[2] >> 16) | (vv[3] & 0xffff0000u), (vv[4] >> 16) | (vv[5] & 0xffff0000u), (vv[6] >> 16) | (vv[7] & 0xffff0000u)};
            if (wave == 0) *(LAS f32x2*)(lds + HQ_DV + 8 * lane) = (tt[0] * tt[1]) * (tt[2] * tt[3]);
        }
        __syncthreads();
        if (ci + 1 < 36) {
            const bool nx = (ci + 1) >= 4; const int Ln = nx ? LX : LC, rbn = nx ? b * LX : TX + b * LC, jn = nx ? ci + 1 - 4 : ci + 1;
#pragma unroll
            for (int m = 0; m < 8; ++m) { const int i = 64 * jn + 8 * wave + m; const int t = dir ? (Ln - 1 - i) : i; const bf16_t* p = HG + (size_t)(rbn + t) * HGW;
                pzq[m] = *(const unsigned*)(p + colq); pzf[m] = *(const unsigned*)(p + colf); pzv[m] = *(const unsigned*)(p + colv); }
        }
        _Pragma("unroll") for (int rr_ = 0; rr_ < 1 + ((HG_REP >> 2) & 1); ++rr_)
        if (need_o) for (int vb = wave; vb < 10; vb += 8) {
            const int I = (vb >= 6) ? 3 : (vb >= 3) ? 2 : (vb >= 1) ? 1 : 0, Jp = vb - I * (I + 1) / 2;
            f32x4 c = (f32x4){0.f, 0.f, 0.f, 0.f};
#pragma unroll
            for (int ks = 0; ks < 4; ++ks) {
                const bf16x8 af = *(const LAS bf16x8*)(lds + HQ_KV + (16 * vb + lr) * RS_K + ks * 64 + lq * 16);
                const bf16x8 bf = *(const LAS bf16x8*)(lds + HQ_QP + (16 * I + lr) * RS_K + ks * 64 + lq * 16);
                c = MFMA16(af, bf, c);
            }
            if (I == Jp) { c.x = (4 * lq + 0 <= lr) ? c.x : 0.f; c.y = (4 * lq + 1 <= lr) ? c.y : 0.f; c.z = (4 * lq + 2 <= lr) ? c.z : 0.f; c.w = (4 * lq + 3 <= lr) ? c.w : 0.f; }
            *(LAS u32x2*)(lds + HQ_AM + (16 * I + lr) * RS_S + (16 * Jp + 4 * lq) * 2) = (u32x2){pk2(c.x, c.y), pk2(c.z, c.w)};
        }
        {
#pragma unroll
            for (int kti = 0; kti < 2; ++kti) { const f32x4 dv = *(const LAS f32x4*)(lds + HQ_DV + (16 * (kt0 + kti) + 4 * lq) * 4);
#pragma unroll
                for (int vti = 0; vti < 4; ++vti) S[kti][vti] *= dv; }
#pragma unroll
            for (int ks = 0; ks < 2; ++ks) { bf16x8 af[2];
#pragma unroll
                for (int kti = 0; kti < 2; ++kti) af[kti] = *(const LAS bf16x8*)(lds + HQ_KHT + (16 * (kt0 + kti) + lr) * RS_S + ks * 64 + lq * 16);
#pragma unroll
                for (int vti = 0; vti < 4; ++vti) { const bf16x8 bf = *(const LAS bf16x8*)(lds + HQ_VT + (16 * (vt0 + vti) + lr) * RS_S + ks * 64 + lq * 16);
#pragma unroll
                    for (int kti = 0; kti < 2; ++kti) S[kti][vti] = MFMA16(af[kti], bf, S[kti][vti]); } }
        }
        __syncthreads();
        _Pragma("unroll") for (int rr_ = 0; rr_ < 1 + ((HG_REP >> 3) & 1); ++rr_)
        if (need_o) {
            f32x4 o[4];
#pragma unroll
            for (int it = 0; it < 4; ++it) o[it] = (f32x4){0.f, 0.f, 0.f, 0.f};
#pragma unroll
            for (int ks = 0; ks < 4; ++ks) { const bf16x8 af = *(const LAS bf16x8*)(lds + HQ_ST + (16 * wave + lr) * RS_K + ks * 64 + lq * 16);
#pragma unroll
                for (int it = 0; it < 4; ++it) { const bf16x8 bf = *(const LAS bf16x8*)(lds + HQ_QT + (16 * it + lr) * 256 + (((ks * 4 + lq) ^ lr) << 4)); o[it] = MFMA16(af, bf, o[it]); } }
#pragma unroll
            for (int ks = 0; ks < 2; ++ks) { const bf16x8 af = *(const LAS bf16x8*)(lds + HQ_VT + (16 * wave + lr) * RS_S + ks * 64 + lq * 16);
#pragma unroll
                for (int it = 0; it < 4; ++it) { if (ks == 1 && it < 2) continue; const bf16x8 bf = *(const LAS bf16x8*)(lds + HQ_AM + (16 * it + lr) * RS_S + ks * 64 + lq * 16); o[it] = MFMA16(af, bf, o[it]); } }
#pragma unroll
            for (int it = 0; it < 4; ++it) opk[it] = (u32x2){pk2(o[it].x, o[it].y), pk2(o[it].z, o[it].w)};
            oci = ci;
        }
        __syncthreads();
#pragma unroll
        for (int kti = 0; kti < 2; ++kti)
#pragma unroll
            for (int vti = 0; vti < 4; ++vti) { const f32x4 s = S[kti][vti];
                *(LAS u32x2*)(lds + HQ_ST + (16 * (vt0 + vti) + lr) * RS_K + (16 * (kt0 + kti) + 4 * lq) * 2) = (u32x2){pk2(s.x, s.y), pk2(s.z, s.w)}; }
    }
    flush_o();
    __syncthreads();
}

constexpr int HY_CSTR = 8224;
__device__ __forceinline__ void hyena_unit(const Args& a, LAS unsigned char* lds, int l, bool isx, int c) {
    const int tid = opaque(TIDX(a)), lane = tid & 63, wave = __builtin_amdgcn_readfirstlane(tid >> 6);
    const int L = isx ? LX : LC, NA = L / 64;
    const int ZSTR = (NA + 6) * 128 + 16, XSTR = L * 2 + 16;
    const int OFF_Z = 0, OFF_X0 = 8 * ZSTR, OFF_KC = OFF_X0 + 8 * XSTR;
    const bf16_t* HT = isx ? WSP(bf16_t, WS_HTX) : WSP(bf16_t, WS_HTC);
    const bf16_t* kr = (isx ? WSP(bf16_t, WS_KRX) + (size_t)l * 512 * KRX_LD + (size_t)c * KRX_LD : WSP(bf16_t, WS_KRC) + (size_t)l * 512 * KRC_LD + (size_t)c * KRC_LD);
    __syncthreads();
    for (int i = tid; i < 8 * 2 * 24; i += 512) { const int b = i / 48, r = i % 48; const int off = (r < 24) ? r * 16 : (192 + L) * 2 + (r - 24) * 16; *(LAS u32x4*)(lds + OFF_Z + b * ZSTR + off) = (u32x4){0u, 0u, 0u, 0u}; }
    {
        float w[3][3], bias[3];
#pragma unroll
        for (int s = 0; s < 3; ++s) { bias[s] = a.in[I_HCB][l * 1536 + s * 512 + c];
#pragma unroll
            for (int j = 0; j < 3; ++j) w[s][j] = a.in[I_HCW][(l * 3 + j) * 1536 + s * 512 + c]; }
        for (int g = tid; g < L; g += 512) { const int b = g / (L / 8), t0 = (g % (L / 8)) * 8;
            float uc[3][8];
#pragma unroll
            for (int s = 0; s < 3; ++s) { const bf16_t* p = HT + ((size_t)b * 1536 + s * 512 + c) * L;
                const u32x4 v = *(const u32x4*)(p + t0); float u[10];
                u[0] = (t0 > 0) ? bf2f(p[t0 - 1]) : 0.f; u[9] = (t0 + 8 < L) ? bf2f(p[t0 + 8]) : 0.f;
                u[1] = bflo(v.x); u[2] = bfhi(v.x); u[3] = bflo(v.y); u[4] = bfhi(v.y); u[5] = bflo(v.z); u[6] = bfhi(v.z); u[7] = bflo(v.w); u[8] = bfhi(v.w);
#pragma unroll
                for (int i = 0; i < 8; ++i) uc[s][i] = w[s][0] * u[i] + w[s][1] * u[i + 1] + w[s][2] * u[i + 2] + bias[s]; }
            float z[8];
#pragma unroll
            for (int i = 0; i < 8; ++i) z[i] = uc[1][i] * uc[0][i];
            *(LAS u32x4*)(lds + OFF_Z + b * ZSTR + (192 + t0) * 2) = (u32x4){pk2(z[0], z[1]), pk2(z[2], z[3]), pk2(z[4], z[5]), pk2(z[6], z[7])};
            *(LAS u32x4*)(lds + OFF_X0 + b * XSTR + t0 * 2) = (u32x4){pk2(uc[2][0], uc[2][1]), pk2(uc[2][2], uc[2][3]), pk2(uc[2][4], uc[2][5]), pk2(uc[2][6], uc[2][7])};
        }
    }
    for (int g = tid; g < 2 * L / 8; g += 512) {
        const u32x4 qa = *(const u32x4*)(kr + 8 * g), qb = *(const u32x4*)(kr + 8 * g + 8);
        const unsigned cw[8] = {qa.x, qa.y, qa.z, qa.w, qb.x, qb.y, qb.z, qb.w};
#pragma unroll
        for (int s = 0; s < 8; ++s) { const int d = s >> 1; u32x4 o;
            if (s & 1) o = (u32x4){__builtin_amdgcn_alignbit(cw[d + 1], cw[d], 16), __builtin_amdgcn_alignbit(cw[d + 2], cw[d + 1], 16), __builtin_amdgcn_alignbit(cw[d + 3], cw[d + 2], 16), __builtin_amdgcn_alignbit(cw[d + 4], cw[d + 3], 16)};
            else o = (u32x4){cw[d], cw[d + 1], cw[d + 2], cw[d + 3]};
            *(LAS u32x4*)(lds + OFF_KC + s * HY_CSTR + g * 16) = o; } }
    __syncthreads();
    const int lr = lane & 15, lq = lane >> 4;
    if (4 * wave < NA) {
        f32x4 acc[4][2];
#pragma unroll
        for (int mt = 0; mt < 4; ++mt) { acc[mt][0] = (f32x4){0.f, 0.f, 0.f, 0.f}; acc[mt][1] = acc[mt][0]; }
        const int bb = lr & 7, ao = lr >> 3;
        const int dlo = 4 * wave - NA + 1, dhi = 4 * wave + 3;
        for (int d = dlo; d <= dhi; ++d) {
#pragma unroll
            for (int ks = 0; ks < 2; ++ks) {
                bf16x8 bfr[2];
#pragma unroll
                for (int nt = 0; nt < 2; ++nt) { const int ap = 2 * (2 * wave + nt) + ao; bfr[nt] = *(const LAS bf16x8*)(lds + OFF_Z + bb * ZSTR + ((ap - d + 3) * 64 + 32 * ks + 8 * lq) * 2); }
#pragma unroll
                for (int mt = 0; mt < 4; ++mt) { const int rp = 16 * mt + lr; const int i0 = 32 * ks + 8 * lq - rp - 64 * d + L; const int s = i0 & 7;
                    const bf16x8 afr = *(const LAS bf16x8*)(lds + OFF_KC + s * HY_CSTR + (i0 - s) * 2);
                    acc[mt][0] = MFMA16(afr, bfr[0], acc[mt][0]); acc[mt][1] = MFMA16(afr, bfr[1], acc[mt][1]); }
            }
        }
        const float dbias = a.in[I_HBIAS][l * 512 + c];
        bf16_t* hy = (isx ? WSP(bf16_t, WS_HTX) : WSP(bf16_t, WS_HTC)) + ((size_t)bb * 1536 + c) * L;
#pragma unroll
        for (int mt = 0; mt < 4; ++mt)
#pragma unroll
            for (int nt = 0; nt < 2; ++nt) { const int ap = 2 * (2 * wave + nt) + ao; const f32x4 y = acc[mt][nt]; const int t = 64 * ap + 16 * mt + 4 * lq;
                const u32x2 zw = *(const LAS u32x2*)(lds + OFF_Z + bb * ZSTR + (192 + t) * 2), xw = *(const LAS u32x2*)(lds + OFF_X0 + bb * XSTR + t * 2);
                const float o0 = bflo(xw.x) * (y.x + dbias * bflo(zw.x)), o1 = bfhi(xw.x) * (y.y + dbias * bfhi(zw.x)), o2 = bflo(xw.y) * (y.z + dbias * bflo(zw.y)), o3 = bfhi(xw.y) * (y.w + dbias * bfhi(zw.y));
                *(u32x2*)(hy + t) = (u32x2){pk2(o0, o1), pk2(o2, o3)}; }
    }
}

constexpr int CW_DSYNC = 20480;
__device__ __forceinline__ void dft_fold(const Args& a, LAS unsigned char* lds, int l, int rank, int nranks) {
    const int tid = opaque(TIDX(a)), lane = tid & 63, wave = __builtin_amdgcn_readfirstlane(tid >> 6);
    LAS unsigned char* rowb = lds + wave * 8192;
    bf16_t* FT = WSP(bf16_t, WS_FTX);
    for (int r = rank * 8 + wave; r < NB * 4 * 65; r += nranks * 8) {
        const int b = r / 260, q_ = r % 260, g = q_ / 65, cp = q_ % 65; const bool hasS = cp >= 1 && cp <= 63;
        bf16_t* p = FT + ((size_t)b * 512 + g * 128 + cp) * 4096;
        bf16_t* pmr = FT + ((size_t)b * 512 + g * 128 + (128 - cp)) * 4096;
        u32x4 v[8];
#pragma unroll
        for (int j = 0; j < 4; ++j) v[j] = *(const u32x4*)(p + 8 * lane + 512 * j);
#pragma unroll
        for (int j = 4; j < 8; ++j) v[j] = hasS ? *(const u32x4*)(p + 8 * lane + 512 * j) : (u32x4){0u, 0u, 0u, 0u};
#pragma unroll
        for (int j = 0; j < 8; ++j) *(LAS u32x4*)(rowb + (lane + 64 * j) * 16) = v[j];
        asm volatile("s_waitcnt vmcnt(0) lgkmcnt(0)" ::: "memory");
        const float nyq = bf2f(*(const LAS bf16_t*)(rowb + 1024 * 2));
#pragma unroll
        for (int q = 0; q < 4; ++q) { const int o = lane + 64 * q; const bool isc = q < 2; const int t0 = 8 * (isc ? o : o - 128), base = isc ? 0 : 2048;
            const u32x4 own = *(const LAS u32x4*)(rowb + (base + t0) * 2);
            const u32x4 xm_ = *(const LAS u32x4*)(rowb + (base + LX - t0 - 8) * 2);
            const unsigned y0w = *(const LAS unsigned*)(rowb + (base + (t0 > 0 ? LX - t0 : 0)) * 2);
            const float f[8] = {bflo(own.x), bfhi(own.x), bflo(own.y), bfhi(own.y), bflo(own.z), bfhi(own.z), bflo(own.w), bfhi(own.w)};
            const float x[8] = {bflo(xm_.x), bfhi(xm_.x), bflo(xm_.y), bfhi(xm_.y), bflo(xm_.z), bfhi(xm_.z), bflo(xm_.w), bfhi(xm_.w)};
            const float sg = isc ? 1.0f : -1.0f;
            float ov[8];
            ov[0] = (t0 > 0) ? f[0] + sg * bflo(y0w) : (isc ? f[0] : nyq);
#pragma unroll
            for (int i = 1; i < 8; ++i) ov[i] = f[i] + sg * x[8 - i];
            const u32x4 w4 = (u32x4){pk2(ov[0], ov[1]), pk2(ov[2], ov[3]), pk2(ov[4], ov[5]), pk2(ov[6], ov[7])};
            *(u32x4*)(p + 8 * o) = w4;
            if (hasS) { u32x4 m4 = w4;
                if (!isc) { m4.x ^= (o == 128) ? 0x80000000u : 0x80008000u; m4.y ^= 0x80008000u; m4.z ^= 0x80008000u; m4.w ^= 0x80008000u; }
                *(u32x4*)(pmr + 8 * o) = m4; } }
        asm volatile("s_waitcnt lgkmcnt(0)" ::: "memory");
    }
    if (l == 0) {
        bf16_t* FC = WSP(bf16_t, WS_FTC);
        for (int r = rank * 8 + wave; r < NB * 4 * 65; r += nranks * 8) {
            const int b = r / 260, q_ = r % 260, g = q_ / 65, cp = q_ % 65; const bool hasS = cp >= 1 && cp <= 63;
            bf16_t* p = FC + ((size_t)b * 512 + g * 128 + cp) * 512;
            if (hasS) { u32x4 v = *(const u32x4*)(p + 8 * lane);
                if (lane >= 32) { v.x ^= 0x80008000u; v.y ^= 0x80008000u; v.z ^= 0x80008000u; v.w ^= 0x80008000u; }
                *(u32x4*)(FC + ((size_t)b * 512 + g * 128 + (128 - cp)) * 512 + 8 * lane) = v; }
            else if (lane >= 32) *(u32x4*)(p + 8 * lane) = (u32x4){0u, 0u, 0u, 0u};
        }
    }
}

constexpr int NPH_LAYER = 10, NPH = 2 + 2 * NPH_LAYER;
__global__ void __launch_bounds__(512, 2) mk_fwd(Args a_in) {
    Args a = a_in; a.wv = __builtin_amdgcn_readfirstlane((int)threadIdx.x >> 6);
    extern __shared__ __attribute__((aligned(16))) unsigned char lds_raw[];
    LAS unsigned char* lds = (LAS unsigned char*)lds_raw;
    const int bid = blockIdx.x, G = gridDim.x;
    volatile LAS unsigned* LCTL = (volatile LAS unsigned*)(lds + LDS_CTL);
    if (a.wv == 0) LCTL[lane_id_()] = 0u;
    __syncthreads();
    unsigned* ctl = WSP(unsigned, WS_CTL);
    XcdBarrier bar; bar.bar = ctl + CW_BAR; bar.x = 0; bar.st = nullptr;
    bar.wv = a.wv;
    if (!MK_MULTI) bar = xcd_barrier_post(ctl + CW_BAR, LCTL, a.wv);
    const int lo = a.ph_lo, hi = a.ph_hi;
#ifndef PHASE_MASK
#define PHASE_MASK 0xFFFFF
#endif
#define ON(b) ((PHASE_MASK >> (b)) & 1)
#ifndef REPEAT_MASK
#define REPEAT_MASK 0
#endif
#define REP(b) _Pragma("unroll") for (int rep_ = 0; rep_ < 1 + ((REPEAT_MASK >> (b)) & 1); ++rep_)
#define REP2(b) _Pragma("unroll") for (int rep2_ = 0; rep2_ < 1 + ((REPEAT_MASK >> (b)) & 1); ++rep2_)
#define IN(k) (lo <= (k) && (k) < hi)
#define SEAM(k) do { if (IN(k) && IN((k) + 1)) xcd_barrier(bar); } while (0)

    if (ON(0) && IN(0)) REP(0) { p0_prologue(a, lds, bid, G); }
    SEAM(0);
    for (int l = 0; l < 2; ++l) {
        const int pb = 1 + NPH_LAYER * l;
        const bf16_t* WinT = WSP(bf16_t, WS_WIN + l * WIN_BYTES); const bf16_t* WoutT = WSP(bf16_t, WS_WOUT + l * WOUT_BYTES);
        const bf16_t* WguT = WSP(bf16_t, WS_WGU + l * WGU_BYTES); const bf16_t* WdT = WSP(bf16_t, WS_WD + l * WD_BYTES);
        if (ON(1) && IN(pb + 0)) REP(1) { if (l == 0) norm_pass<0>(a, bid, G); else norm_pass<1>(a, bid, G); }
        SEAM(pb + 0);
        if (ON(2) && IN(pb + 1)) REP(2) {
            const int nMg = (l == 0) ? TT / 256 : TX / 256, nfull = nMg * (NIN / 256);
            StrideOrder<MapG1> S{MapG1{WSP(bf16_t, WS_XM), WinT, nMg, nfull}, nfull + (l == 0 ? 0 : (TC / 256) * 12), G, bid};
            EpiG1 E{WSP(bf16_t, WS_FTX), WSP(bf16_t, WS_FTC), WSP(bf16_t, WS_HTX), WSP(bf16_t, WS_HTC), WSP(bf16_t, WS_HG)};
            pg8::gemm_phase<EpiG1, StrideOrder<MapG1>>(lds, D, D, D, S, E, a.wv);
            if (l == 0 && G == 256 && bid >= 224) { __syncthreads(); tail_copy(a, lds, TS_G1, TAILC_G1, bid - 224, 32); }
            if (l == 1 && G == 256 && bid >= 96) { __syncthreads(); tail_copy(a, lds, TS_G1L1, TAILC_G1L1, bid - 96, 160); }
        }
        SEAM(pb + 1);
        if (ON(3) && IN(pb + 2)) REP(3) {
            if (ON(12)) REP2(12) { for (int u = bid; u < 128; u += G) hgrn_seq(a, lds, l, u); }
            if (ON(13)) REP2(13) { const int cD = (bid + G - (128 % G)) % G, nd = G < 128 ? G : 128;
                if (cD < nd) {
                    dft_fold(a, lds, l, cD, nd);
                    asm volatile("s_waitcnt vmcnt(0)" ::: "memory");
                    __syncthreads();
                    if (TIDX(a) == 0) { unsigned* cnt = ctl + CW_DSYNC + 64 * l; __builtin_amdgcn_fence(__ATOMIC_RELEASE, "agent"); asm volatile("s_waitcnt vmcnt(0)" ::: "memory");
                        (void)xb_add(cnt, 1u); XB_SPIN(xb_ld(cnt) < (unsigned)nd, ctl + CW_BAR);
                        __builtin_amdgcn_fence(__ATOMIC_ACQUIRE, "agent"); asm volatile("s_waitcnt vmcnt(0)" ::: "memory"); }
                    __syncthreads();
                }
                StrideOrder<MapDftX> S1{MapDftX{WSP(bf16_t, WS_DFTX), WSP(bf16_t, WS_FTX)}, 128, G, cD}; EpiDft E{WSP(bf16_t, WS_MIX)};
                pg8::gemm_phase<EpiDft, StrideOrder<MapDftX>>(lds, LX, 2 * LX, LX, S1, E, a.wv); }
            if (ON(14) && l == 0) { StrideOrder<MapDftC> S1{MapDftC{WSP(bf16_t, WS_DFTC), WSP(bf16_t, WS_FTC)}, 16, G, (bid + G - (240 % G)) % G}; EpiDft E{WSP(bf16_t, WS_MIX)};
                pg8::gemm_phase<EpiDft, StrideOrder<MapDftC>>(lds, 2 * LC, 2 * LC, 2 * LC, S1, E, a.wv); }
            if (ON(15)) REP2(15) {
                const int nq = (l == 0) ? 1024 : 512;
                for (;;) {
                    __syncthreads();
                    if (TIDX(a) == 0) LCTL[4] = xb_add(ctl + CW_QUEUE + 64 * (l + 2 * rep_ + 4 * rep2_), 1u);
                    __syncthreads();
                    const int it = (int)LCTL[4];
                    if (it >= nq) break;
                    hyena_unit(a, lds, l, it < 512, it & 511);
                }
            }
            if (G == 256 && bid >= 128) { __syncthreads(); tail_copy(a, lds, l == 0 ? TS_M0 : TS_M1, l == 0 ? TAILC_M0 : TAILC_M1, bid - 128, 128); }
            __syncthreads();
        }
        SEAM(pb + 2);
        if (ON(4) && IN(pb + 3)) REP(4) hgrn_out_pass(a, lds, l, bid, G);
        SEAM(pb + 3);
        if (ON(5) && IN(pb + 4)) REP(5) {
            const int nM = (l == 0) ? TT / 256 : TX / 256;
            StrideOrder<MapG2> S{MapG2{WSP(bf16_t, WS_MIX), WoutT, nM}, nM * (D / 256), G, bid};
            EpiG2 E{a.in[I_X], a.in[I_CTX], WSP(bf16_t, WS_XCUR), WSP(float, WS_MOD) + (size_t)l * 9 * MODW, l};
            pg8::gemm_phase<EpiG2, StrideOrder<MapG2>>(lds, D, D, D, S, E, a.wv);
            if (l == 0 && G == 256 && bid >= 64) { __syncthreads(); tail_copy(a, lds, TS_G2, TAILC_G2, bid - 64, 192); }
        }
        SEAM(pb + 4);
        if (ON(6) && IN(pb + 5)) REP(6) n2_pass(a, lds, l, bid, G);
        SEAM(pb + 5);
        if (ON(7) && IN(pb + 6)) REP(7) topk_pass(a, lds, l, bid, G);
        SEAM(pb + 6);
        if (ON(9) && IN(pb + 8)) REP(9) {
            const int ntm = (l == 0) ? ROWS_E / 256 : (NB * CAPX) / 256;
            const int vcu = (G % 8 == 0) ? (bid % 8) * (G / 8) + bid / 8 : bid;
            StrideOrder<MapE1> S{MapE1{WSP(bf16_t, WS_XM), WguT, ntm}, NE * ntm * 8, G, vcu};
            EpiE1 E{WSP(bf16_t, WS_HID)};
            LAS int* gidx = (LAS int*)(lds + pg8::STAGE_BYTES);
            { const int tid_ = opaque(TIDX(a)); Unit uu;
              for (int i = 0; i < pg8::GIDX_UNITS && S.next(i, uu); ++i) { if (tid_ < 256) gidx[i * 256 + tid_] = WSP(int, WS_IDX)[uu.aux * ROWS_E + uu.pm * 256 + tid_]; }
              __syncthreads(); }
            pg8::gemm_phase<EpiE1, StrideOrder<MapE1>, true, true, true, false>(lds, D, D, D, S, E, a.wv, gidx);
            if (l == 0 && G == 256 && vcu >= 128) { __syncthreads(); tail_copy(a, lds, TS_E1, TAILC_E1, vcu - 128, 128); }
        }
        SEAM(pb + 8);
        if (ON(10) && IN(pb + 9)) REP(10) {
            const int ntm = (l == 0) ? ROWS_E / 256 : (NB * CAPX) / 256;
            const int vcu = (G % 8 == 0) ? (bid % 8) * (G / 8) + bid / 8 : bid;
            StrideOrder<MapE2> S{MapE2{WSP(bf16_t, WS_HID), WdT, ntm}, NE * ntm * 8, G, vcu};
            EpiE2 E{WSP(bf16_t, WS_Y), WSP(float, WS_GATE)};
            pg8::gemm_phase<EpiE2, StrideOrder<MapE2>, true, true, false, true, true>(lds, 128, FF, FF, S, E, a.wv);
            if (l == 0 && G == 256 && vcu >= 128) { __syncthreads(); tail_copy(a, lds, TS_E2, TAILC_E2, vcu - 128, 128); }
        }
        SEAM(pb + 9);
    }
    if (ON(11) && IN(NPH - 1)) REP(11) norm_pass<2>(a, bid, G);
#undef IN
#undef SEAM
}

extern "C" void kernel_launch(void* const* d_in, const int* in_sizes, int n_in, void* d_out, int out_size, void* d_ws, size_t ws_size, hipStream_t stream) {
    static int grid = 0;
    if (grid == 0) {
        if (n_in != 29 || in_sizes[0] != TX * D || out_size != TX * D || ws_size < WS_END) {
            fprintf(stderr, "kernel_launch: unexpected shapes (n_in %d, in0 %d, out %d, ws %zu, need %zu); nothing launched\n", n_in, n_in > 0 ? in_sizes[0] : -1, out_size, ws_size, (size_t)WS_END); grid = -1; return; }
        int dev = 0, cus = 0, per_cu = 0;
        if (hipGetDevice(&dev) != hipSuccess || hipDeviceGetAttribute(&cus, hipDeviceAttributeMultiprocessorCount, dev) != hipSuccess) { grid = -1; return; }
        if (hipFuncSetAttribute((const void*)mk_fwd, hipFuncAttributeMaxDynamicSharedMemorySize, LDS_BYTES) != hipSuccess) { fprintf(stderr, "kernel_launch: hipFuncSetAttribute failed\n"); grid = -1; return; }
        if (hipOccupancyMaxActiveBlocksPerMultiprocessor(&per_cu, (const void*)mk_fwd, 512, LDS_BYTES) != hipSuccess || per_cu < 1)
            fprintf(stderr, "kernel_launch: note: occupancy query reports %d workgroups per CU\n", per_cu);
        (void)hipGetLastError();
        if (cus * pg8::GIDX_UNITS < NE * (ROWS_E / 256) * 8) { fprintf(stderr, "kernel_launch: %d CUs: E1's row-index table is too small\n", cus); grid = -1; return; }
        grid = cus;
    }
    if (grid < 0) return;
    if (hipMemsetAsync((char*)d_ws + WS_CTL, 0, CTL_ZERO_BYTES, stream) != hipSuccess) return;
    Args a{};
    for (int i = 0; i < 29; ++i) a.in[i] = (const float*)d_in[i];
    a.out = (float*)d_out; a.ws = (unsigned char*)d_ws;
#if MK_MULTI
    for (int p = 0; p < NPH; ++p) { a.ph_lo = p; a.ph_hi = p + 1; hipLaunchKernelGGL(mk_fwd, dim3(grid), dim3(512), LDS_BYTES, stream, a); }
#else
    a.ph_lo = 0; a.ph_hi = NPH; hipLaunchKernelGGL(mk_fwd, dim3(grid), dim3(512), LDS_BYTES, stream, a);
#endif
    const hipError_t le = hipPeekAtLastError();
    if (le != hipSuccess) fprintf(stderr, "kernel_launch: launch failed: %s\n", hipGetErrorName(le));
}
```
